# Optimizing an MI355X kernel written in HIP

```python
import jax, jax.numpy as jnp
from jax import lax
import numpy as np

D_MODEL = 1024
BATCH = 2
SEQ = 8192
DEPTH = 4

CHUNK = 64
Q_BLOCK = 128
N_A_LAYERS = DEPTH // 2
N_B_LAYERS = DEPTH - N_A_LAYERS
SB_HEADS = 16
SB_HEAD_DIM = D_MODEL // SB_HEADS
MLA_HEADS = 16
MLA_NOPE_DIM = 64
MLA_ROPE_DIM = 32
MLA_V_DIM = 64
MLA_Q_RANK = 384
MLA_KV_RANK = 256
D_FF = 4 * D_MODEL
ROPE_THETA = 10000.0
NORM_EPS = 1e-6
MAX_POS_OFFSET = 4096

kernel_name = "yoco_stickbreak_mla_hybrid"


def rms_norm(x, g):
    xf = x.astype(jnp.float32)
    y = xf * lax.rsqrt(jnp.mean(xf * xf, axis=-1, keepdims=True) + NORM_EPS)
    return (y * g.astype(jnp.float32)).astype(x.dtype)


def rope_tables(positions):
    inv_freq = ROPE_THETA ** (-jnp.arange(0, MLA_ROPE_DIM, 2, dtype=jnp.float32) / MLA_ROPE_DIM)
    ang = positions.astype(jnp.float32)[..., None] * inv_freq
    return jnp.cos(ang), jnp.sin(ang)


def apply_rope(t, cos, sin):
    half = MLA_ROPE_DIM // 2
    t1 = t[..., :half].astype(jnp.float32)
    t2 = t[..., half:].astype(jnp.float32)
    out = jnp.concatenate([t1 * cos - t2 * sin, t2 * cos + t1 * sin], axis=-1)
    return out.astype(t.dtype)


def to_query_blocks(t):
    b, s, h, d = t.shape
    return t.reshape(b, s // Q_BLOCK, Q_BLOCK, h, d).transpose(1, 0, 3, 2, 4)


def from_query_blocks(t):
    nb, b, qb, h, d = t.shape
    return t.transpose(1, 0, 2, 3, 4).reshape(b, nb * qb, h * d)


def stick_breaking_attention(h, w_qkv, w_o):
    b, s, _ = h.shape
    qkv = (h @ w_qkv).reshape(b, s, 3, SB_HEADS, SB_HEAD_DIM)
    q, k, v = qkv[:, :, 0], qkv[:, :, 1], qkv[:, :, 2]
    k_h = k.transpose(0, 2, 1, 3)
    v_h = v.transpose(0, 2, 1, 3)
    q_blocks = to_query_blocks(q)
    scale = SB_HEAD_DIM ** -0.5
    key_pos = jnp.arange(s)

    def block(args):
        q_blk, blk_idx = args
        q_pos = blk_idx * Q_BLOCK + jnp.arange(Q_BLOCK)
        z = jnp.einsum('bhqd,bhkd->bhqk', q_blk, k_h).astype(jnp.float32) * scale
        causal = key_pos[None, :] < q_pos[:, None]
        log_beta = jax.nn.log_sigmoid(z)
        log_keep = jnp.where(causal, jax.nn.log_sigmoid(-z), 0.0)
        shifted = jnp.concatenate([log_keep[..., 1:], jnp.zeros_like(log_keep[..., :1])], axis=-1)
        log_survive = lax.cumsum(shifted, axis=3, reverse=True)
        weights = jnp.where(causal, jnp.exp(log_beta + log_survive), 0.0)
        return jnp.einsum('bhqk,bhkd->bqhd', weights.astype(v_h.dtype), v_h)

    out = lax.map(block, (q_blocks, jnp.arange(s // Q_BLOCK)))
    return from_query_blocks(out) @ w_o


def mla_shared_kv(h, w_dkv, kv_lat_norm, w_ukv, cos, sin):
    b, s, _ = h.shape
    down = h @ w_dkv
    c_kv = rms_norm(down[..., :MLA_KV_RANK], kv_lat_norm)
    k_rope = apply_rope(down[..., MLA_KV_RANK:], cos, sin)
    kv = (c_kv @ w_ukv).reshape(b, s, MLA_HEADS, MLA_NOPE_DIM + MLA_V_DIM)
    k_nope = kv[..., :MLA_NOPE_DIM].transpose(0, 2, 1, 3)
    v = kv[..., MLA_NOPE_DIM:].transpose(0, 2, 1, 3)
    return k_nope, k_rope, v


def mla_attention(h, w_dq, q_lat_norm, w_uq, w_o, k_nope, k_rope, v, cos, sin):
    b, s, _ = h.shape
    c_q = rms_norm(h @ w_dq, q_lat_norm)
    q = (c_q @ w_uq).reshape(b, s, MLA_HEADS, MLA_NOPE_DIM + MLA_ROPE_DIM)
    q_nope = q[..., :MLA_NOPE_DIM]
    q_rope = apply_rope(q[..., MLA_NOPE_DIM:], cos[:, :, None, :], sin[:, :, None, :])
    qn_blocks = to_query_blocks(q_nope)
    qr_blocks = to_query_blocks(q_rope)
    scale = (MLA_NOPE_DIM + MLA_ROPE_DIM) ** -0.5
    key_chunk = jnp.arange(s) // CHUNK

    def block(args):
        qn, qr, blk_idx = args
        q_chunk = (blk_idx * Q_BLOCK + jnp.arange(Q_BLOCK)) // CHUNK
        scores = (jnp.einsum('bhqd,bhkd->bhqk', qn, k_nope)
                  + jnp.einsum('bhqr,bkr->bhqk', qr, k_rope)).astype(jnp.float32) * scale
        allowed = key_chunk[None, :] <= q_chunk[:, None]
        probs = jax.nn.softmax(jnp.where(allowed, scores, -jnp.inf), axis=-1)
        return jnp.einsum('bhqk,bhkd->bqhd', probs.astype(v.dtype), v)

    out = lax.map(block, (qn_blocks, qr_blocks, jnp.arange(s // Q_BLOCK)))
    return from_query_blocks(out) @ w_o


def squared_relu_mlp(h, w1, w2):
    return jnp.square(jax.nn.relu(h @ w1)) @ w2


def setup_inputs(seed: int = 0) -> dict:
    key = jax.random.key(seed)
    ks = jax.random.split(key, 20)

    def w(k, shape, fan_in, gain=1.0):
        return jax.random.normal(k, shape, jnp.float32) * (gain * fan_in ** -0.5)

    def gains(k, shape):
        return 1.0 + 0.02 * jax.random.normal(k, shape, jnp.float32)

    out_gain = (2.0 * DEPTH) ** -0.5
    x = jax.random.normal(ks[0], (BATCH, SEQ, D_MODEL), jnp.float32)
    offsets = jax.random.randint(ks[1], (BATCH, 1), 0, MAX_POS_OFFSET, dtype=jnp.int32)
    positions = offsets + jnp.arange(SEQ, dtype=jnp.int32)[None, :]
    return {
        "x": x,
        "positions": positions,
        "attn_norm": gains(ks[2], (DEPTH, D_MODEL)),
        "mlp_norm": gains(ks[3], (DEPTH, D_MODEL)),
        "sb_w_qkv": w(ks[4], (N_A_LAYERS, D_MODEL, 3 * D_MODEL), D_MODEL),
        "sb_w_o": w(ks[5], (N_A_LAYERS, D_MODEL, D_MODEL), D_MODEL, out_gain),
        "kv_norm": gains(ks[6], (D_MODEL,)),
        "mla_w_dkv": w(ks[7], (D_MODEL, MLA_KV_RANK + MLA_ROPE_DIM), D_MODEL),
        "mla_kv_lat_norm": gains(ks[8], (MLA_KV_RANK,)),
        "mla_w_ukv": w(ks[9], (MLA_KV_RANK, MLA_HEADS * (MLA_NOPE_DIM + MLA_V_DIM)), MLA_KV_RANK),
        "mla_w_dq": w(ks[10], (N_B_LAYERS, D_MODEL, MLA_Q_RANK), D_MODEL),
        "mla_q_lat_norm": gains(ks[11], (N_B_LAYERS, MLA_Q_RANK)),
        "mla_w_uq": w(ks[12], (N_B_LAYERS, MLA_Q_RANK, MLA_HEADS * (MLA_NOPE_DIM + MLA_ROPE_DIM)), MLA_Q_RANK),
        "mla_w_o": w(ks[13], (N_B_LAYERS, MLA_HEADS * MLA_V_DIM, D_MODEL), MLA_HEADS * MLA_V_DIM, out_gain),
        "mlp_w1": w(ks[14], (DEPTH, D_MODEL, D_FF), D_MODEL),
        "mlp_w2": w(ks[15], (DEPTH, D_FF, D_MODEL), D_FF, out_gain),
        "final_norm": gains(ks[16], (D_MODEL,)),
    }


def reference(x, positions, attn_norm, mlp_norm, sb_w_qkv, sb_w_o, kv_norm, mla_w_dkv,
              mla_kv_lat_norm, mla_w_ukv, mla_w_dq, mla_q_lat_norm, mla_w_uq, mla_w_o,
              mlp_w1, mlp_w2, final_norm):
    cos, sin = rope_tables(positions)
    k_nope = k_rope = v = None
    for layer in range(DEPTH):
        if layer < N_A_LAYERS:
            x = x + stick_breaking_attention(rms_norm(x, attn_norm[layer]),
                                             sb_w_qkv[layer], sb_w_o[layer])
        else:
            if layer == N_A_LAYERS:
                k_nope, k_rope, v = mla_shared_kv(rms_norm(x, kv_norm), mla_w_dkv,
                                                  mla_kv_lat_norm, mla_w_ukv, cos, sin)
            j = layer - N_A_LAYERS
            x = x + mla_attention(rms_norm(x, attn_norm[layer]), mla_w_dq[j], mla_q_lat_norm[j],
                                  mla_w_uq[j], mla_w_o[j], k_nope, k_rope, v, cos, sin)
        x = x + squared_relu_mlp(rms_norm(x, mlp_norm[layer]), mlp_w1[layer], mlp_w2[layer])
    return rms_norm(x, final_norm)
```

```cpp
#include <hip/hip_runtime.h>
#include <hip/hip_cooperative_groups.h>
#include <cstdio>
#include <cstdint>
namespace cg = cooperative_groups;
namespace pg8 {
#define PG8_LAS __attribute__((address_space(3)))
typedef unsigned short bf16_t;
typedef short bf16x8 __attribute__((ext_vector_type(8)));
typedef float f32x4 __attribute__((ext_vector_type(4)));
typedef unsigned u32x4 __attribute__((ext_vector_type(4)));
constexpr int BM = 256, BK = 64, HALF = 128, HTB = HALF * BK * 2  , STAGE_BYTES = 8 * HTB, NXCD = 8, WGM = 8;

__host__ __device__ __forceinline__ int lds_byte(int r, int c) { const int st = (r >> 4) * 2 + (c >> 5), rr = r & 15, cc = c & 31, ob = rr * 64 + cc * 2; return st * 1024 + (ob ^ (((ob >> 9) & 1) << 5)); }
__host__ __device__ __forceinline__ void stage_rc(int b, int& R, int& C) { const int st = b / 1024, sb = b % 1024, swz = sb ^ (((sb >> 9) & 1) << 5); R = (st >> 1) * 16 + swz / 64; C = (st & 1) * 32 + (swz % 64) / 2; }
__host__ __device__ __forceinline__ int perm32(int rho) { const int n = rho >> 4, i = rho & 15; return 8 * (i >> 2) + 4 * n + (i & 3); }

struct Unit { int pm, pn; };
struct Gemm { const bf16_t* A; const bf16_t* Bt; int M, N, K; };

struct StaticOrder {
    int nM, nN, nwg, G, c;
    __host__ __device__ void init(int M, int N, int G_, int c_) { nM = M / BM; nN = N / BM; nwg = nM * nN; G = G_; c = c_; }
    __host__ __device__ bool next(int i, Unit& u) const {
        const long L = (long)i * G + c; if (L >= nwg) return false;
        int wgid = (int)L; { const int q = nwg / NXCD, r = nwg % NXCD, xcd = wgid % NXCD, off = wgid / NXCD; wgid = (xcd < r ? xcd * (q + 1) : r * (q + 1) + (xcd - r) * q) + off; }
        const int nig = WGM * nN, gid = wgid / nig, fm = gid * WGM, gsz = (nM - fm) < WGM ? (nM - fm) : WGM;
        u.pm = fm + ((wgid % nig) % gsz); u.pn = (wgid % nig) / gsz; return true;
    }
    __device__ __forceinline__ void a_ready(const Unit&) const {}
    __device__ __forceinline__ void done(const Unit&) const {}
};

__device__ __forceinline__ unsigned cvt_pk_bf16(float lo, float hi) { unsigned r; asm volatile("v_cvt_pk_bf16_f32 %0, %1, %2" : "=v"(r) : "v"(lo), "v"(hi)); return r; }
typedef float f32x2 __attribute__((ext_vector_type(2)));
template <int ACT  > struct EpiBf16 {
    static constexpr bool PERM = true, AFTER_DRAIN = false;
    bf16_t* O; int ldc; int split_cols; size_t split_stride; float scale0, scale;
    __device__ __forceinline__ void operator()(const f32x4 (&acc)[2][2][4][2], const Unit& u, int wr, int wc, int fr, int fq) const {
        const int row0 = u.pm * BM + wr * 64 + fr; int colt = u.pn * BM; bf16_t* base = O;
        float sc = scale; if (split_cols) { const int t = colt / split_cols; base += (size_t)t * split_stride; colt -= t * split_cols; if (t == 0) sc *= scale0; }
        const int col0 = colt + wc * 32 + 8 * fq;
#pragma unroll
        for (int ai = 0; ai < 2; ++ai)
#pragma unroll
            for (int m = 0; m < 4; ++m) { bf16_t* rowp = base + (size_t)(row0 + ai * HALF + m * 16) * ldc + col0;
#pragma unroll
                for (int bj = 0; bj < 2; ++bj) { f32x4 v0 = acc[ai][bj][m][0], v1 = acc[ai][bj][m][1];
                    if (ACT == 2) {
#pragma unroll
                        for (int e = 0; e < 4; ++e) { const float a = __builtin_fmaxf(v0[e], 0.f), b = __builtin_fmaxf(v1[e], 0.f); v0[e] = a * a; v1[e] = b * b; } }
                    v0 = v0 * sc; v1 = v1 * sc; u32x4 w; w.x = cvt_pk_bf16(v0[0], v0[1]); w.y = cvt_pk_bf16(v0[2], v0[3]); w.z = cvt_pk_bf16(v1[0], v1[1]); w.w = cvt_pk_bf16(v1[2], v1[3]);
                    *(u32x4*)(rowp + bj * HALF) = w; } }
    }
};
template <bool RES> struct EpiF32 {
    static constexpr bool PERM = false, AFTER_DRAIN = false;
    const float* base; float* out; int ldc;
    __device__ __forceinline__ void operator()(const f32x4 (&acc)[2][2][4][2], const Unit& u, int wr, int wc, int fr, int fq) const {
        const int col0 = u.pn * BM + wc * 32 + 4 * fq;
#pragma unroll
        for (int ai = 0; ai < 2; ++ai)
#pragma unroll
            for (int m = 0; m < 4; ++m) { const size_t off = (size_t)(u.pm * BM + ai * HALF + wr * 64 + m * 16 + fr) * ldc + col0;
#pragma unroll
                for (int bj = 0; bj < 2; ++bj)
#pragma unroll
                    for (int n = 0; n < 2; ++n) { f32x4 o = acc[ai][bj][m][n]; if (RES) o = o + *(const f32x4*)(base + off + bj * HALF + n * 16); *(f32x4*)(out + off + bj * HALF + n * 16) = o; }
                asm volatile("" ::: "memory"); }
    }
};
template <class Epi, class Sched, bool ALIGN_EPI = false, bool SP2 = false>
__device__ __forceinline__ void gemm_phase(PG8_LAS unsigned char* lds, const Gemm g, const Sched& S, const Epi& E) {
    int tid_ = threadIdx.x; asm volatile("" : "+v"(tid_));
    const int tid = tid_, wid = __builtin_amdgcn_readfirstlane(tid >> 6), lane = tid & 63, wr = wid >> 2, wc = wid & 3, fr = lane & 15, fq = lane >> 4;
    const int K = g.K, nt = K / BK;
    unsigned voffA[2], voffB[2];
#pragma unroll
    for (int i = 0; i < 2; ++i) { int R, C; stage_rc(tid * 16 + i * 8192, R, C); const int Rb = Epi::PERM ? ((R & ~31) + perm32(R & 31)) : R;
        voffA[i] = (unsigned)(R * K + C) * 2u; voffB[i] = (unsigned)(Rb * K + C) * 2u; }
    const size_t kstep = (size_t)(BK * 2);
    const size_t hstep = (size_t)HALF * K * 2;
    const size_t tstep = 2 * hstep;
    const unsigned ldsw = (unsigned)wid * 1024u;
    const int aoff = lds_byte(wr * 64 + fr, fq * 8), boff = lds_byte(wc * 32 + fr, fq * 8);
#define PG8_SA(b, h) (((b) * 2 + (h)) * HTB)
#define PG8_SB(b, h) ((4 + (b) * 2 + (h)) * HTB)
#define PG8_STAGE(bufoff, gbase, voff) do { _Pragma("unroll") for (int _i = 0; _i < 2; ++_i) \
        __builtin_amdgcn_global_load_lds((const unsigned*)((const char*)(gbase) + (voff)[_i]), (PG8_LAS unsigned*)(lds + (bufoff) + ldsw + _i * 8192), 16, 0, 0); } while (0)
#define PG8_LDA(dst, b, h) do { _Pragma("unroll") for (int m = 0; m < 4; ++m) _Pragma("unroll") for (int k = 0; k < 2; ++k) dst[m][k] = *(const PG8_LAS bf16x8*)(lds + PG8_SA(b, h) + aoff + m * 2048 + k * 1024); } while (0)
#define PG8_LDB(dst, b, h) do { _Pragma("unroll") for (int n = 0; n < 2; ++n) _Pragma("unroll") for (int k = 0; k < 2; ++k) dst[n][k] = *(const PG8_LAS bf16x8*)(lds + PG8_SB(b, h) + boff + n * 2048 + k * 1024); } while (0)
#define PG8_MMA(ai, bj, At, Bt) do { __builtin_amdgcn_s_setprio(1); _Pragma("unroll") for (int m = 0; m < 4; ++m) _Pragma("unroll") for (int n = 0; n < 2; ++n) _Pragma("unroll") for (int k = 0; k < 2; ++k) \
        acc[ai][bj][m][n] = __builtin_amdgcn_mfma_f32_16x16x32_bf16(Bt[n][k], At[m][k], acc[ai][bj][m][n], 0, 0, 0); __builtin_amdgcn_s_setprio(0); } while (0)
#define PG8_WAIT_V(n) asm volatile("s_waitcnt vmcnt(" #n ")" ::: "memory")
#define PG8_WAIT_L(n) asm volatile("s_waitcnt lgkmcnt(" #n ")" ::: "memory")
#define PG8_BAR __builtin_amdgcn_s_barrier()
#define PG8_SCHED __builtin_amdgcn_sched_barrier(0)
    Unit cur, nxt; int ui = 0;
    if (!S.next(0, cur)) return;
    f32x4 acc[2][2][4][2];
#pragma unroll
    for (int a = 0; a < 2; ++a)
#pragma unroll
        for (int b = 0; b < 2; ++b)
#pragma unroll
            for (int m = 0; m < 4; ++m)
#pragma unroll
                for (int n = 0; n < 2; ++n) acc[a][b][m][n] = (f32x4){0.f, 0.f, 0.f, 0.f};
    bf16x8 At[4][2], B0[2][2], B1[2][2];
    const char* cA = (const char*)g.A + (size_t)cur.pm * tstep; const char* cB = (const char*)g.Bt + (size_t)cur.pn * tstep;
    S.a_ready(cur);
    if constexpr (SP2) {
        PG8_STAGE(PG8_SB(0, 0), cB, voffB); PG8_STAGE(PG8_SB(0, 1), cB + hstep, voffB); PG8_STAGE(PG8_SA(0, 0), cA, voffA); PG8_STAGE(PG8_SA(0, 1), cA + hstep, voffA);
        if (wr == 1) PG8_BAR;
        PG8_WAIT_V(2); PG8_BAR;
        PG8_STAGE(PG8_SB(1, 0), cB + kstep, voffB); PG8_STAGE(PG8_SA(1, 0), cA + kstep, voffA); PG8_STAGE(PG8_SB(1, 1), cB + hstep + kstep, voffB);
        PG8_WAIT_V(6); PG8_BAR;
    } else {
        PG8_STAGE(PG8_SB(0, 0), cB, voffB); PG8_STAGE(PG8_SA(0, 0), cA, voffA); PG8_STAGE(PG8_SB(0, 1), cB + hstep, voffB); PG8_STAGE(PG8_SA(0, 1), cA + hstep, voffA);
        if (wr == 1) PG8_BAR;
        PG8_WAIT_V(4); PG8_BAR;
        PG8_STAGE(PG8_SB(1, 0), cB + kstep, voffB); PG8_STAGE(PG8_SA(1, 0), cA + kstep, voffA); PG8_STAGE(PG8_SB(1, 1), cB + hstep + kstep, voffB);
        PG8_WAIT_V(6); PG8_BAR;
    }
    for (;;) {
        const bool has_next = S.next(ui + 1, nxt);
        const char* nA = has_next ? (const char*)g.A + (size_t)nxt.pm * tstep : cA; const char* nB = has_next ? (const char*)g.Bt + (size_t)nxt.pn * tstep : cB;
        for (int t = 0; t < nt; t += 2) {
            const bool last = (t == nt - 2);
            const char* a1 = cA + (size_t)(t + 1) * kstep;
            const char* a2 = last ? nA : cA + (size_t)(t + 2) * kstep; const char* b2 = last ? nB : cB + (size_t)(t + 2) * kstep;
            const char* a3 = a2 + kstep; const char* b3 = b2 + kstep;
            if (last && has_next) S.a_ready(nxt);
            if constexpr (SP2) {
            PG8_LDB(B0, 0, 0); PG8_LDB(B1, 0, 1); PG8_SCHED; PG8_LDA(At, 0, 0); PG8_STAGE(PG8_SA(1, 1), a1 + hstep, voffA);
            PG8_WAIT_V(8); PG8_WAIT_L(0); PG8_BAR; PG8_MMA(0, 0, At, B0); PG8_MMA(0, 1, At, B1); PG8_BAR; PG8_SCHED;
            PG8_LDA(At, 0, 1); PG8_STAGE(PG8_SB(0, 0), b2, voffB); PG8_STAGE(PG8_SB(0, 1), b2 + hstep, voffB); PG8_STAGE(PG8_SA(0, 0), a2, voffA);
            PG8_WAIT_V(8); PG8_WAIT_L(0); PG8_BAR; PG8_MMA(1, 0, At, B0); PG8_MMA(1, 1, At, B1); PG8_BAR; PG8_SCHED;
            PG8_LDB(B0, 1, 0); PG8_LDB(B1, 1, 1); PG8_SCHED; PG8_LDA(At, 1, 0); PG8_STAGE(PG8_SA(0, 1), a2 + hstep, voffA);
            PG8_WAIT_V(8); PG8_WAIT_L(0); PG8_BAR; PG8_MMA(0, 0, At, B0); PG8_MMA(0, 1, At, B1); PG8_BAR; PG8_SCHED;
            PG8_LDA(At, 1, 1); PG8_STAGE(PG8_SB(1, 0), b3, voffB); PG8_STAGE(PG8_SB(1, 1), b3 + hstep, voffB); PG8_STAGE(PG8_SA(1, 0), a3, voffA);
            PG8_WAIT_V(8); PG8_WAIT_L(0); PG8_BAR; PG8_MMA(1, 0, At, B0); PG8_MMA(1, 1, At, B1); PG8_BAR; PG8_SCHED;
            } else {
            PG8_LDB(B0, 0, 0); PG8_SCHED; PG8_LDA(At, 0, 0); PG8_STAGE(PG8_SA(1, 1), a1 + hstep, voffA);
            PG8_WAIT_L(8); PG8_BAR; PG8_WAIT_L(0); PG8_MMA(0, 0, At, B0); PG8_BAR; PG8_SCHED;
            PG8_LDB(B1, 0, 1); PG8_STAGE(PG8_SB(0, 0), b2, voffB);
            PG8_BAR; PG8_WAIT_L(0); PG8_MMA(0, 1, At, B1); PG8_BAR;
            PG8_LDA(At, 0, 1); PG8_STAGE(PG8_SA(0, 0), a2, voffA);
            PG8_BAR; PG8_WAIT_L(0); PG8_MMA(1, 0, At, B0); PG8_BAR; PG8_SCHED;
            PG8_STAGE(PG8_SB(0, 1), b2 + hstep, voffB);
            PG8_WAIT_V(6); PG8_BAR; PG8_MMA(1, 1, At, B1); PG8_BAR;
            PG8_LDB(B0, 1, 0); PG8_SCHED; PG8_LDA(At, 1, 0); PG8_STAGE(PG8_SA(0, 1), a2 + hstep, voffA);
            PG8_WAIT_L(8); PG8_BAR; PG8_WAIT_L(0); PG8_MMA(0, 0, At, B0); PG8_BAR; PG8_SCHED;
            PG8_LDB(B1, 1, 1); PG8_STAGE(PG8_SB(1, 0), b3, voffB);
            PG8_BAR; PG8_WAIT_L(0); PG8_MMA(0, 1, At, B1); PG8_BAR;
            PG8_LDA(At, 1, 1); PG8_STAGE(PG8_SA(1, 0), a3, voffA);
            PG8_BAR; PG8_WAIT_L(0); PG8_MMA(1, 0, At, B0); PG8_BAR; PG8_SCHED;
            PG8_STAGE(PG8_SB(1, 1), b3 + hstep, voffB);
            PG8_WAIT_V(6); PG8_BAR; PG8_MMA(1, 1, At, B1); PG8_BAR;
            }
        }
        if constexpr (ALIGN_EPI) { if (wr == 0) PG8_BAR; }
        if constexpr (!Epi::AFTER_DRAIN) { E(acc, cur, wr, wc, fr, fq); S.done(cur); }
        if (!has_next) break;
#pragma unroll
        for (int a = 0; a < 2; ++a)
#pragma unroll
            for (int b = 0; b < 2; ++b)
#pragma unroll
                for (int m = 0; m < 4; ++m)
#pragma unroll
                    for (int n = 0; n < 2; ++n) acc[a][b][m][n] = (f32x4){0.f, 0.f, 0.f, 0.f};
        cur = nxt; cA = nA; cB = nB; ++ui;
        if constexpr (ALIGN_EPI) { if (wr == 1) PG8_BAR; }
    }
    PG8_WAIT_V(0);
    if constexpr (!ALIGN_EPI) { if (wr == 0) PG8_BAR; }
    PG8_BAR;
    if constexpr (Epi::AFTER_DRAIN) { E.fused(acc, cur, wr, wc, fr, fq, lds, wid, lane); S.done(cur); }
#undef PG8_SA
#undef PG8_SB
#undef PG8_STAGE
#undef PG8_LDA
#undef PG8_LDB
#undef PG8_MMA
#undef PG8_WAIT_V
#undef PG8_WAIT_L
#undef PG8_BAR
#undef PG8_SCHED
}
}
namespace att {
#define ALAS __attribute__((address_space(3)))
typedef unsigned short bf16_t;
typedef short bf16x8 __attribute__((ext_vector_type(8)));
typedef short s16x4 __attribute__((ext_vector_type(4)));
typedef float f32x16 __attribute__((ext_vector_type(16)));
typedef float f32x4 __attribute__((ext_vector_type(4)));
typedef unsigned u32x4 __attribute__((ext_vector_type(4)));
typedef float f32x2_t __attribute__((ext_vector_type(2))); typedef __bf16 bf16x2_t __attribute__((ext_vector_type(2)));
constexpr int SEQ = 8192;
typedef ALAS char* ALAS_char_t;
__device__ __forceinline__ int crow(int r, int hi) { return (r & 3) + 8 * (r >> 2) + 4 * hi; }
#define SBAR() __builtin_amdgcn_sched_barrier(0)
__device__ __forceinline__ void glds16(const void* gsrc, unsigned lds_dst) { unsigned keep;
  asm volatile("s_mov_b32 %0, m0\n\ts_mov_b32 m0, %2\n\ts_nop 0\n\tglobal_load_lds_dwordx4 %1, off\n\ts_mov_b32 m0, %0" : "=&s"(keep) : "v"(gsrc), "s"(lds_dst) : "memory"); }
__device__ __forceinline__ unsigned cvtpk_s(float lo, float hi) { f32x2_t v = {lo, hi}; bf16x2_t b = __builtin_convertvector(v, bf16x2_t); return __builtin_bit_cast(unsigned, b); }
__device__ __forceinline__ float bf2f(short v) { return __uint_as_float(((unsigned)(unsigned short)v) << 16); }
__device__ __forceinline__ unsigned short f2bf(float f) { unsigned u = __builtin_bit_cast(unsigned, f); return (unsigned short)((u + 0x7fffu + ((u >> 16) & 1u)) >> 16); }
#define MFMA32(a, b, c) __builtin_amdgcn_mfma_f32_32x32x16_bf16((a), (b), (c), 0, 0, 0)
template <int NK> __device__ __forceinline__ void qkt(f32x16& p0, f32x16& p1, const ALAS char* kb, const bf16x8* qr, const f32x16& cinit) {
#pragma unroll
  for (int d0 = 0; d0 < NK; ++d0) {
    const bf16x8 b0 = *(const ALAS bf16x8*)(kb + d0 * 2048);
    const bf16x8 b1 = *(const ALAS bf16x8*)(kb + d0 * 2048 + 512);
    if (d0 == 0) { p0 = MFMA32(b0, qr[0], cinit); p1 = MFMA32(b1, qr[0], cinit); }
    else { p0 = MFMA32(b0, qr[d0], p0); p1 = MFMA32(b1, qr[d0], p1); } }
}
__device__ __forceinline__ void pv(f32x16* o, int vb, bf16x8 pa0, bf16x8 pa1, bf16x8 pa2, bf16x8 pa3) {
#pragma unroll
  for (int d0 = 0; d0 < 2; ++d0) { s16x4 lo[4], hi[4];
#pragma unroll
    for (int ks = 0; ks < 4; ++ks) {
      asm volatile("ds_read_b64_tr_b16 %0,%1 offset:%c2" : "=&v"(lo[ks]) : "v"(vb), "i"(d0 * 4096 + ks * 1024) : "memory");
      asm volatile("ds_read_b64_tr_b16 %0,%1 offset:%c2" : "=&v"(hi[ks]) : "v"(vb), "i"(d0 * 4096 + ks * 1024 + 512) : "memory"); }
    asm volatile("s_waitcnt lgkmcnt(0)" ::: "memory"); SBAR();
#define PK(k) (bf16x8){lo[k][0], lo[k][1], lo[k][2], lo[k][3], hi[k][0], hi[k][1], hi[k][2], hi[k][3]}
    o[d0] = MFMA32(pa0, PK(0), o[d0]); o[d0] = MFMA32(pa1, PK(1), o[d0]); o[d0] = MFMA32(pa2, PK(2), o[d0]); o[d0] = MFMA32(pa3, PK(3), o[d0]);
#undef PK
  }
}
__device__ __forceinline__ float rowmax(const f32x16& p0, const f32x16& p1) {
  float a = __builtin_fmaxf(p0[0], p1[0]), b = __builtin_fmaxf(p0[1], p1[1]);
#pragma unroll
  for (int r = 2; r < 16; r += 2) { a = __builtin_fmaxf(a, __builtin_fmaxf(p0[r], p1[r])); b = __builtin_fmaxf(b, __builtin_fmaxf(p0[r + 1], p1[r + 1])); }
  const float m = __builtin_fmaxf(a, b);
  auto rr = __builtin_amdgcn_permlane32_swap(__float_as_uint(m), __float_as_uint(m), false, false);
  return __builtin_fmaxf(__uint_as_float(rr[0]), __uint_as_float(rr[1]));
}
#define PKW(P, B) cvtpk_s(P[B], P[B + 1])
__device__ __forceinline__ void store_o(const f32x16* o, bf16_t* Ow, int pitch, ALAS bf16_t* stg, int lane) {
  const int r32 = lane & 31, hi = lane >> 5;
#pragma unroll
  for (int r = 0; r < 16; ++r) { const int orow = crow(r, hi);
#pragma unroll
    for (int d0 = 0; d0 < 2; ++d0) stg[orow * 64 + d0 * 32 + r32] = f2bf(o[d0][r]); }
  asm volatile("s_waitcnt lgkmcnt(0)" ::: "memory");
#pragma unroll
  for (int i = 0; i < 4; ++i) { const int row = i * 8 + (lane >> 3), ch = lane & 7; const u32x4 v = *(const ALAS u32x4*)(stg + row * 64 + ch * 8); *(u32x4*)(Ow + (long)row * pitch + ch * 8) = v; }
  asm volatile("s_waitcnt lgkmcnt(0)" ::: "memory");
}

struct SbConsts { bf16x8 T0, T1, ONES; };
__device__ __forceinline__ void sb_consts(SbConsts& c, int lane) {
  const int r = lane & 31, h = lane >> 5;
#pragma unroll
  for (int j = 0; j < 8; ++j) { const int kin = 8 * (j >> 2) + 4 * h + (j & 3); c.T0[j] = (kin > r) ? (short)0x3F80 : (short)0; c.T1[j] = (16 + kin > r) ? (short)0x3F80 : (short)0; c.ONES[j] = (short)0x3F80; }
}
__device__ __forceinline__ void sb_unit(int b, int h, int qblk, const bf16_t* Q, const bf16_t* __restrict__ K, const bf16_t* __restrict__ V, bf16_t* O, ALAS char* wl, const SbConsts& tc) {
  int tid_ = threadIdx.x; asm volatile("" : "+v"(tid_));
  const int lane = tid_ & 63, r32 = lane & 31, hi = lane >> 5;
  const long rowbase = (long)b * SEQ; const int q0 = qblk * 32;
  const bf16_t* Qw = Q + (rowbase + q0) * 1024 + h * 64;
  const bf16_t* Kh = K + rowbase * 1024 + h * 64; const bf16_t* Vh = V + rowbase * 1024 + h * 64;
  const unsigned kslot = (unsigned)__builtin_amdgcn_readfirstlane((int)(unsigned)(uintptr_t)wl), vslot = kslot + 8192u;
  bf16x8 qr[4];
#pragma unroll
  for (int d0 = 0; d0 < 4; ++d0) qr[d0] = *(const bf16x8*)(Qw + (long)r32 * 1024 + d0 * 16 + hi * 8);
  f32x16 o[2]; o[0] = f32x16{}; o[1] = f32x16{}; float C = 0.f;
  const ALAS char* kp = wl + hi * 1024 + r32 * 16;
  const int vb = (int)vslot + ((lane >> 4) & 1) * 32 + (lane & 3) * 8 + (4 * hi + ((lane & 15) >> 2)) * 64;
  const int tdiag = q0 >> 6;
  for (int t = tdiag; t >= 0; --t) {
    { const bf16_t* ks = Kh + (long)(64 * t + lane) * 1024;
#pragma unroll
      for (int c = 0; c < 8; ++c) glds16(ks + c * 8, kslot + c * 1024);
      const bf16_t* vs = Vh + (long)(64 * t + (lane >> 2)) * 1024 + (lane & 3) * 8;
#pragma unroll
      for (int p = 0; p < 8; ++p) glds16(vs + (long)(16 * (p & 3)) * 1024 + (p >> 2) * 32, vslot + p * 1024); }
    asm volatile("s_waitcnt vmcnt(0)" ::: "memory");
    f32x16 y0, y1; { f32x16 z = f32x16{}; qkt<4>(y0, y1, kp, qr, z); }
    if (t == tdiag) { const int qrel = (q0 & 63) + r32;
#pragma unroll
      for (int r = 0; r < 16; ++r) { const int kv = 4 * hi + (r & 3) + 8 * (r >> 2); if (kv >= qrel) y0[r] = -1e30f; if (kv + 32 >= qrel) y1[r] = -1e30f; } }
    f32x16 L0, L1;
#pragma unroll
    for (int r = 0; r < 16; ++r) {
      { const float y = y0[r]; float s = __builtin_amdgcn_logf(1.f + __builtin_amdgcn_exp2f(y)); s = y > 60.f ? y : s; L0[r] = -s; y0[r] = y - s; }
      { const float y = y1[r]; float s = __builtin_amdgcn_logf(1.f + __builtin_amdgcn_exp2f(y)); s = y > 60.f ? y : s; L1[r] = -s; y1[r] = y - s; } }
    u32x4 w0, w1, w2, w3;
    w0 = (u32x4){PKW(L0, 0), PKW(L0, 2), PKW(L0, 4), PKW(L0, 6)}; w1 = (u32x4){PKW(L0, 8), PKW(L0, 10), PKW(L0, 12), PKW(L0, 14)};
    w2 = (u32x4){PKW(L1, 0), PKW(L1, 2), PKW(L1, 4), PKW(L1, 6)}; w3 = (u32x4){PKW(L1, 8), PKW(L1, 10), PKW(L1, 12), PKW(L1, 14)};
    f32x16 cv;
#pragma unroll
    for (int r = 0; r < 16; ++r) cv[r] = C;
    f32x16 S0 = MFMA32(tc.T0, __builtin_bit_cast(bf16x8, w0), cv); S0 = MFMA32(tc.T1, __builtin_bit_cast(bf16x8, w1), S0);
    S0 = MFMA32(tc.ONES, __builtin_bit_cast(bf16x8, w2), S0); S0 = MFMA32(tc.ONES, __builtin_bit_cast(bf16x8, w3), S0);
    f32x16 S1 = MFMA32(tc.T0, __builtin_bit_cast(bf16x8, w2), cv); S1 = MFMA32(tc.T1, __builtin_bit_cast(bf16x8, w3), S1);
#pragma unroll
    for (int r = 0; r < 16; ++r) { y0[r] = __builtin_amdgcn_exp2f(y0[r] + S0[r]); y1[r] = __builtin_amdgcn_exp2f(y1[r] + S1[r]); }
    { const float tot = S0[0] + L0[0]; auto rr = __builtin_amdgcn_permlane32_swap(__float_as_uint(tot), __float_as_uint(tot), false, false); C = __uint_as_float(rr[0]); }
    w0 = (u32x4){PKW(y0, 0), PKW(y0, 2), PKW(y0, 4), PKW(y0, 6)}; w1 = (u32x4){PKW(y0, 8), PKW(y0, 10), PKW(y0, 12), PKW(y0, 14)};
    w2 = (u32x4){PKW(y1, 0), PKW(y1, 2), PKW(y1, 4), PKW(y1, 6)}; w3 = (u32x4){PKW(y1, 8), PKW(y1, 10), PKW(y1, 12), PKW(y1, 14)};
    SBAR(); pv(o, vb, __builtin_bit_cast(bf16x8, w0), __builtin_bit_cast(bf16x8, w1), __builtin_bit_cast(bf16x8, w2), __builtin_bit_cast(bf16x8, w3));
    if (__all(C < -151.f)) break;
  }
  store_o(o, O + (rowbase + q0) * 1024 + h * 64, 1024, (ALAS bf16_t*)wl, lane);
}

constexpr int KSLOT = 12288, VSLOT = 8192, NSLOT = 3;
constexpr int LDS_K = 0, LDS_V = NSLOT * KSLOT, LDS_WS = LDS_V + NSLOT * VSLOT, LDS_OST = LDS_WS + 8 * 64 * 4, LDS_BYTES = LDS_OST + 8 * 4096;
#define WAIT_BAR(N) asm volatile("s_waitcnt vmcnt(" #N ") lgkmcnt(0)\n\ts_barrier" ::: "memory")
template <int THRL> __device__ __forceinline__ void mla_unit(int b, int h, int qb, const bf16_t* QB, const bf16_t* __restrict__ KVB, const bf16_t* __restrict__ KR, const float* __restrict__ CS, bf16_t* O, ALAS char* shm) {
  int tid_ = threadIdx.x; asm volatile("" : "+v"(tid_));
  const int tid = tid_, lane = tid & 63, r32 = lane & 31, hi = lane >> 5; const int wid = __builtin_amdgcn_readfirstlane(tid >> 6);
  const long rowbase = (long)b * SEQ; const int q0 = qb * 256;
  const unsigned lds0 = (unsigned)(uintptr_t)shm;
  ALAS float* wsf = (ALAS float*)(shm + LDS_WS) + wid * 64;
  const int NT = (q0 + 256) / 64;
  const long qrow = rowbase + q0 + wid * 32 + r32;
  bf16x8 qr[6];
  { const bf16_t* Qw = QB + qrow * 1536 + h * 96;
#pragma unroll
    for (int d0 = 0; d0 < 6; ++d0) qr[d0] = *(const bf16x8*)(Qw + d0 * 16 + hi * 8);
    const float* cs = CS + qrow * 32 + 8 * hi;
    const f32x4 c0 = *(const f32x4*)(cs), c1 = *(const f32x4*)(cs + 4), s0 = *(const f32x4*)(cs + 16), s1 = *(const f32x4*)(cs + 20);
#pragma unroll
    for (int j = 0; j < 8; ++j) { const float c = j < 4 ? c0[j & 3] : c1[j & 3], s = j < 4 ? s0[j & 3] : s1[j & 3];
      const float t1 = bf2f(qr[4][j]), t2 = bf2f(qr[5][j]); qr[4][j] = (short)f2bf(t1 * c - t2 * s); qr[5][j] = (short)f2bf(t2 * c + t1 * s); } }
  const bf16_t* ksrc = KVB + (rowbase + lane) * 2048 + h * 128 + wid * 8;
  const bf16_t* rsrc = KR + (rowbase + lane) * 32 + (wid & 3) * 8;
  const bf16_t* vsrc = KVB + (rowbase + 16 * (wid & 3) + (lane >> 2)) * 2048 + h * 128 + 64 + (wid >> 2) * 32 + (lane & 3) * 8;
  const unsigned kdst = lds0 + LDS_K + wid * 1024, rdst = lds0 + LDS_K + (8 + (wid & 3)) * 1024, vdst = lds0 + LDS_V + wid * 1024;
#define DMA(t, s) do { glds16(ksrc + (long)(t) * 64 * 2048, (unsigned)__builtin_amdgcn_readfirstlane((int)(kdst + (s) * KSLOT))); \
    glds16(rsrc + (long)(t) * 64 * 32, (unsigned)__builtin_amdgcn_readfirstlane((int)(rdst + (s) * KSLOT))); \
    glds16(vsrc + (long)(t) * 64 * 2048, (unsigned)__builtin_amdgcn_readfirstlane((int)(vdst + (s) * VSLOT))); } while (0)
  asm volatile("s_waitcnt vmcnt(0)" ::: "memory");
  DMA(0, 0); DMA(1, 1);
  float mhat = 0.f, l_reg = 0.f; f32x16 o[2]; o[0] = f32x16{}; o[1] = f32x16{}; f32x16 negm = f32x16{};
  bool first = true;
  const ALAS char* kp0 = (const ALAS char*)shm + LDS_K + hi * 1024 + r32 * 16;
  const int vb0 = (int)(lds0 + LDS_V) + ((lane >> 4) & 1) * 32 + (lane & 3) * 8 + (4 * hi + ((lane & 15) >> 2)) * 64;
  int slot = 0, slot2 = 2;
  for (int t = 0; t < NT; ++t) {
    if (t + 1 < NT) WAIT_BAR(3); else WAIT_BAR(0);
    if (t + 2 < NT) DMA(t + 2, slot2);
    const int jb = t - (NT - 4);
    if (jb <= (wid >> 1)) {
      f32x16 c0, c1; qkt<6>(c0, c1, kp0 + slot * KSLOT, qr, negm);
      const float rm = rowmax(c0, c1);
      if (first || __any(rm > (float)THRL)) {
        const float dl = first ? rm : __builtin_fmaxf(rm, 0.f); mhat += dl;
#pragma unroll
        for (int r = 0; r < 16; ++r) { c0[r] -= dl; c1[r] -= dl; negm[r] = -mhat; }
        if (!first) { const float f = __builtin_amdgcn_exp2f(-dl); l_reg *= f; if (hi == 0) wsf[r32] = f;
          asm volatile("s_waitcnt lgkmcnt(0)" ::: "memory");
#pragma unroll
          for (int d = 0; d < 2; ++d)
#pragma unroll
            for (int r = 0; r < 16; ++r) o[d][r] *= wsf[crow(r, hi)]; }
        first = false; }
      float sacc = 0.f;
#pragma unroll
      for (int r = 0; r < 16; ++r) { c0[r] = __builtin_amdgcn_exp2f(c0[r]); c1[r] = __builtin_amdgcn_exp2f(c1[r]); sacc += c0[r] + c1[r]; }
      l_reg += sacc;
      u32x4 w0, w1, w2, w3;
      w0 = (u32x4){PKW(c0, 0), PKW(c0, 2), PKW(c0, 4), PKW(c0, 6)}; w1 = (u32x4){PKW(c0, 8), PKW(c0, 10), PKW(c0, 12), PKW(c0, 14)};
      w2 = (u32x4){PKW(c1, 0), PKW(c1, 2), PKW(c1, 4), PKW(c1, 6)}; w3 = (u32x4){PKW(c1, 8), PKW(c1, 10), PKW(c1, 12), PKW(c1, 14)};
      SBAR(); pv(o, vb0 + slot * VSLOT, __builtin_bit_cast(bf16x8, w0), __builtin_bit_cast(bf16x8, w1), __builtin_bit_cast(bf16x8, w2), __builtin_bit_cast(bf16x8, w3));
    }
    slot = (slot == 2) ? 0 : slot + 1; slot2 = (slot2 == 2) ? 0 : slot2 + 1;
  }
#undef DMA
  { auto rr = __builtin_amdgcn_permlane32_swap(__float_as_uint(l_reg), __float_as_uint(l_reg), false, false); l_reg = __uint_as_float(rr[0]) + __uint_as_float(rr[1]); }
  if (hi == 0) wsf[32 + r32] = l_reg; asm volatile("s_waitcnt lgkmcnt(0)" ::: "memory");
#pragma unroll
  for (int r = 0; r < 16; ++r) { const float rl = __builtin_amdgcn_rcpf(wsf[32 + crow(r, hi)]); o[0][r] *= rl; o[1][r] *= rl; }
  store_o(o, O + (rowbase + q0 + wid * 32) * 1024 + h * 64, 1024, (ALAS bf16_t*)(shm + LDS_OST) + wid * 2048, lane);
  asm volatile("s_waitcnt lgkmcnt(0)\n\ts_barrier" ::: "memory");
}
#undef WAIT_BAR
#undef PKW
#undef SBAR
}
#define GAS __attribute__((address_space(1)))
#define LAS __attribute__((address_space(3)))
typedef unsigned short bf16;
typedef unsigned v4u __attribute__((ext_vector_type(4)));
typedef float f32x4 __attribute__((ext_vector_type(4)));
typedef short bf16x8 __attribute__((ext_vector_type(8)));
typedef GAS unsigned gu32;
typedef GAS unsigned long long gu64;
#define RLX_AGENT __ATOMIC_RELAXED, __HIP_MEMORY_SCOPE_AGENT
#define LDS_WAIT() asm volatile("s_waitcnt lgkmcnt(0)" ::: "memory")
#define VM_WAIT() asm volatile("s_waitcnt vmcnt(0)" ::: "memory")
__device__ __forceinline__ unsigned long long rt() { return __builtin_amdgcn_s_memrealtime(); }
__device__ __forceinline__ unsigned f2bf(float f) { unsigned u = __builtin_bit_cast(unsigned, f); return (u + 0x7fffu + ((u >> 16) & 1u)) >> 16; }
__device__ __forceinline__ unsigned pk2(float lo, float hi) { return f2bf(lo) | (f2bf(hi) << 16); }

#define XB_TMO      128
#define XB_XCNT(j)  (256  + 64 * (j))
#define XB_XSUB(j)  (1280 + 64 * (j))
#define XB_XGEN(j)  (2304 + 64 * (j))
#define XB_TOP      3328
#define XB_TOPGEN   3392
#define XCD_BAR_WORDS 3456
#define XB_SPIN_CAP (1u << 18)

__device__ __forceinline__ unsigned xb_ld(unsigned* p)              { return __hip_atomic_load(p, __ATOMIC_RELAXED, __HIP_MEMORY_SCOPE_AGENT); }
__device__ __forceinline__ unsigned xb_add(unsigned* p, unsigned v) { return __hip_atomic_fetch_add(p, v, __ATOMIC_RELAXED, __HIP_MEMORY_SCOPE_AGENT); }
__device__ __forceinline__ unsigned xb_xcc_id() { return (unsigned)__builtin_amdgcn_s_getreg((3 << 11) | 20) & 0xFu; }
#define XB_SPIN(cond, bar) do { unsigned _sp = 0; while (cond) { __builtin_amdgcn_s_sleep(1); \
    if ((++_sp & 255u) == 0u) { if (xb_ld(&(bar)[XB_TMO])) break; if (_sp > XB_SPIN_CAP) { atomicAdd(&(bar)[XB_TMO], 1u); break; } } } } while (0)

struct XcdBarrier {
    unsigned* bar; unsigned x;
    volatile LAS unsigned* st;
};

__device__ __forceinline__ XcdBarrier xcd_barrier_post(unsigned* bar, volatile LAS unsigned* st) {
    XcdBarrier b; b.bar = bar; b.x = xb_xcc_id(); b.st = st;
    if (threadIdx.x == 0) (void)xb_add(&bar[XB_XCNT(b.x)], 1u);
    return b;
}
__device__ __forceinline__ void xcd_barrier_complete(unsigned* bar, unsigned x, unsigned& nloc, unsigned& nx) {
    const unsigned G = gridDim.x * gridDim.y * gridDim.z;
    unsigned sum, cnt, mine, sp = 0u;
    for (;;) {
        sum = 0u; cnt = 0u; mine = 0u;
#pragma unroll
        for (unsigned j = 0; j < 16; ++j) { const unsigned c = xb_ld(&bar[XB_XCNT(j)]); sum += c; cnt += (c > 0u) ? 1u : 0u; mine = (j == x) ? c : mine; }
        if (sum == G) break;
        __builtin_amdgcn_s_sleep(1);
        if ((++sp & 255u) == 0u) { if (xb_ld(&bar[XB_TMO])) break; if (sp > XB_SPIN_CAP) { atomicAdd(&bar[XB_TMO], 1u); break; } }
    }
    nloc = mine > 0u ? mine : 1u; nx = cnt > 0u ? cnt : 1u;
}

__device__ __forceinline__ void xcd_barrier(const XcdBarrier& b) {
    asm volatile("s_waitcnt vmcnt(0)" ::: "memory");
    __syncthreads();
    if (threadIdx.x == 0) {
        unsigned* bar = b.bar;
        __builtin_amdgcn_s_waitcnt(0);
        unsigned nloc = b.st[0], nx = b.st[1];
        if (nloc == 0u) { xcd_barrier_complete(bar, b.x, nloc, nx); b.st[0] = nloc; b.st[1] = nx; }
        const unsigned old = xb_add(&bar[XB_XSUB(b.x)], 1u);
        const unsigned gen = old / nloc;
        if (old + 1u == (gen + 1u) * nloc) {
            __builtin_amdgcn_fence(__ATOMIC_RELEASE, "agent");
            asm volatile("s_waitcnt vmcnt(0)" ::: "memory");
            const unsigned og = xb_add(&bar[XB_TOP], 1u);
            const unsigned tg = og / nx;
            if (og + 1u == (tg + 1u) * nx) xb_add(&bar[XB_TOPGEN], 1u);
            else XB_SPIN(xb_ld(&bar[XB_TOPGEN]) == tg, bar);
            __builtin_amdgcn_fence(__ATOMIC_ACQUIRE, "agent");
            xb_add(&bar[XB_XGEN(b.x)], 1u);
            asm volatile("s_waitcnt vmcnt(0)" ::: "memory");
        } else {
            XB_SPIN(xb_ld(&bar[XB_XGEN(b.x)]) == gen, bar);
            __builtin_amdgcn_fence(__ATOMIC_ACQUIRE, "agent");
            asm volatile("s_waitcnt vmcnt(0)" ::: "memory");
        }
    }
    __syncthreads();
}
constexpr int NWAVES = 8;
constexpr int SEQ = 8192, M = 2 * SEQ, D = 1024, FF = 4096;
constexpr float NORM_EPS = 1e-6f;
constexpr float LOG2E = 1.4426950408889634f;
constexpr float C2_SB = 0.125f * LOG2E;
constexpr float C2_MLA = 0.10206207261596575f * LOG2E;
constexpr unsigned MB = 1u << 20, KB = 1u << 10;
constexpr unsigned O_CTL = 0, CTL_ZERO_BYTES = 16 * KB;
constexpr unsigned O_WQKV = 2 * MB, O_WOSB = 14 * MB, O_W1 = 18 * MB, O_W2 = 50 * MB, O_WD0 = 82 * MB, O_WD1 = O_WD0 + 1536 * KB, O_WUKV = O_WD1 + 1 * MB,
                   O_WUQ = O_WUKV + 1 * MB, O_WOM = O_WUQ + 2304 * KB;
constexpr unsigned O_XN = 92 * MB;
constexpr unsigned O_Q = 124 * MB, O_K = 156 * MB, O_V = 188 * MB;
constexpr unsigned O_H = 124 * MB;
constexpr unsigned O_KVB = 124 * MB, O_KR = 188 * MB, O_DQ = 189 * MB, O_QB = 189 * MB, O_H2 = 189 * MB, O_CQ = 92 * MB, O_CKV = 104 * MB, O_OB = 92 * MB;
constexpr unsigned O_CS = 253 * MB;
constexpr size_t WS_NEED = (size_t)255 * MB;
static_assert(O_WOM + 4 * MB <= O_XN, "weights");

enum { OP_GB = 0, OP_GR2 = 1, OP_GRES = 2, OP_GF32 = 3, OP_ATTA = 4, OP_ATTB = 5, OP_NORM = 6, OP_LAT = 7, OP_FINAL = 8 };
struct Ph { int op; unsigned a, b, c; int N, K, ldc, p0; float s0, s1; int nosync; };
#define PH_A_LAYER(l) \
  {OP_GB, O_XN, O_WQKV + (l) * 6 * MB, O_Q, 3072, 1024, 1024, 1024, C2_SB, 1.f, 0}, \
  {OP_ATTA, 0, 0, 0, 0, 0, 0, 0, 0.f, 0.f, 0}, \
  {OP_GRES, O_Q, O_WOSB + (l) * 2 * MB, 0, 1024, 1024, 1024, ((l) == 0), 0.f, 0.f, 0}, \
  {OP_NORM, 0, 0, O_XN, 0, 0, 0, 0, 0.f, 0.f, 0}, \
  {OP_GR2, O_XN, O_W1 + (l) * 8 * MB, O_H, 4096, 1024, 4096, 0, 1.f, 1.f, 0}, \
  {OP_GRES, O_H, O_W2 + (l) * 8 * MB, 0, 1024, 4096, 1024, 0, 0.f, 0.f, 0}, \
  {OP_NORM, 0, 0, O_XN, 0, 0, 0, 0, 0.f, 0.f, 0}
__constant__ Ph prog[] = {
  PH_A_LAYER(0), PH_A_LAYER(1),
  {OP_GF32, O_XN, O_WD0, O_DQ, 768, 1024, 768, 0, 0.f, 0.f, 0},
  {OP_LAT, 0, 0, 0, 0, 0, 0, 0, 0.f, 0.f, 0},
  {OP_GB, O_CKV, O_WUKV, O_KVB, 2048, 256, 2048, 0, 1.f, 1.f, 1},
  {OP_GB, O_CQ, O_WUQ, O_QB, 1536, 384, 1536, 0, 1.f, C2_MLA, 0},
  {OP_ATTB, 0, 0, 0, 0, 0, 0, 0, 0.f, 0.f, 0},
  {OP_GRES, O_OB, O_WOM, 0, 1024, 1024, 1024, 0, 0.f, 0.f, 0},
  {OP_NORM, 0, 0, O_XN, 0, 0, 0, 0, 0.f, 0.f, 0},
  {OP_GR2, O_XN, O_W1 + 16 * MB, O_H2, 2048, 1024, 2048, 0, 1.f, 1.f, 0},
  {OP_GRES, O_H2, O_W2 + 16 * MB, 0, 1024, 2048, 1024, 0, 0.f, 0.f, 0},
  {OP_GR2, O_XN, O_W1 + 20 * MB, O_H2, 2048, 1024, 2048, 0, 1.f, 1.f, 0},
  {OP_GRES, O_H2, O_W2 + 20 * MB, 0, 1024, 2048, 1024, 0, 0.f, 0.f, 0},
  {OP_NORM, 0, 0, O_XN, 0, 0, 0, 0, 0.f, 0.f, 0},
  {OP_GF32, O_XN, O_WD1, O_DQ, 512, 1024, 512, 0, 0.f, 0.f, 0},
  {OP_LAT, 0, 0, 0, 0, 0, 0, 1, 0.f, 0.f, 0},
  {OP_GB, O_CQ, O_WUQ + 1152 * KB, O_QB, 1536, 384, 1536, 0, 1.f, C2_MLA, 0},
  {OP_ATTB, 0, 0, 0, 0, 0, 0, 0, 0.f, 0.f, 0},
  {OP_GRES, O_OB, O_WOM + 2 * MB, 0, 1024, 1024, 1024, 0, 0.f, 0.f, 0},
  {OP_NORM, 0, 0, O_XN, 0, 0, 0, 0, 0.f, 0.f, 0},
  {OP_GR2, O_XN, O_W1 + 24 * MB, O_H, 4096, 1024, 4096, 0, 1.f, 1.f, 0},
  {OP_GRES, O_H, O_W2 + 24 * MB, 0, 1024, 4096, 1024, 0, 0.f, 0.f, 0},
  {OP_FINAL, 0, 0, 0, 0, 0, 0, 0, 0.f, 0.f, 1},
};
constexpr int NPH = sizeof(prog) / sizeof(Ph);

constexpr int RING_OFF = 0, RING_BYTES = 131072;
constexpr int LDSCTL_OFF = RING_BYTES, MISC_OFF = LDSCTL_OFF + 320;
constexpr int LDS_BYTES = 147456;
static_assert(att::LDS_BYTES <= RING_BYTES, "attention LDS");
__device__ __forceinline__ float wave_sum(float v) {
#pragma unroll
    for (int o = 1; o < 64; o <<= 1) v += __shfl_xor(v, o);
    return v;
}
__device__ __forceinline__ void p0_transpose_item(const float* W, const float* g, int K, int N, bf16* WT, int row_off, LAS float* scr, int item, int lane) {
    const int nblk = N / 32, kb = item / nblk, nb = item % nblk, k0 = 64 * kb, n0 = 32 * nb;
#pragma unroll 8
    for (int i = 0; i < 32; ++i) { const int kk = 2 * i + (lane >> 5); const float gv = g ? g[k0 + kk] : 1.f; scr[kk * 33 + (lane & 31)] = W[(size_t)(k0 + kk) * N + n0 + (lane & 31)] * gv; }
    LDS_WAIT(); asm volatile("" ::: "memory");
    const int c = lane & 7;
#pragma unroll
    for (int j = 0; j < 4; ++j) { const int n = (lane >> 3) + 8 * j; const LAS float* s = scr + (8 * c) * 33 + n;
        v4u o; o.x = pk2(s[0 * 33], s[1 * 33]); o.y = pk2(s[2 * 33], s[3 * 33]); o.z = pk2(s[4 * 33], s[5 * 33]); o.w = pk2(s[6 * 33], s[7 * 33]);
        *(GAS v4u*)(WT + (size_t)(row_off + n0 + n) * K + k0 + 8 * c) = o; }
    LDS_WAIT(); asm volatile("" ::: "memory");
}
__device__ __forceinline__ void rms_row_to_bf16(const float* xrow, bf16* orow, int lane) {
    const GAS f32x4* xr = (const GAS f32x4*)xrow + lane;
    f32x4 v[4]; float s2 = 0.f;
#pragma unroll
    for (int j = 0; j < 4; ++j) { v[j] = xr[64 * j]; s2 += (v[j].x * v[j].x + v[j].y * v[j].y) + (v[j].z * v[j].z + v[j].w * v[j].w); }
    const float r = 1.f / sqrtf(wave_sum(s2) * (1.f / D) + NORM_EPS);
    GAS unsigned long long* o8 = (GAS unsigned long long*)orow + lane;
#pragma unroll
    for (int j = 0; j < 4; ++j) o8[64 * j] = (unsigned long long)pk2(v[j].x * r, v[j].y * r) | ((unsigned long long)pk2(v[j].z * r, v[j].w * r) << 32);
}

struct Args { const float* in[17]; float* out; unsigned char* ws; };
__global__ void __launch_bounds__(NWAVES * 64, 2) fwd(Args args) {
    extern __shared__ __attribute__((aligned(16))) unsigned char lds[];
    LAS unsigned char* L = (LAS unsigned char*)lds;
    volatile LAS unsigned* MISC = (volatile LAS unsigned*)(L + MISC_OFF);
    const int tid = threadIdx.x, lane = tid & 63, wave = __builtin_amdgcn_readfirstlane(tid >> 6);
    const int G = gridDim.x; const int bx = blockIdx.x; const int vcu = (G % 8 == 0) ? (bx % 8) * (G / 8) + bx / 8 : bx;
    unsigned char* ws = args.ws;
    for (int u = tid; u < (LDS_BYTES - LDSCTL_OFF) / 4; u += NWAVES * 64) ((LAS unsigned*)(L + LDSCTL_OFF))[u] = 0u;
    __syncthreads();
    XcdBarrier bar = xcd_barrier_post((unsigned*)(ws + O_CTL), MISC + 8);
    const int gw = vcu * NWAVES + wave, NGW = G * NWAVES;
    float* X = args.out;

    {
        LAS float* scr = (LAS float*)(L + RING_OFF + wave * 16384);
        int off = 0;
#define CONV(Wp, gp, K_, N_, WTo, roff) do { const int items_ = ((K_) / 64) * ((N_) / 32); int st_ = gw - (off % NGW); if (st_ < 0) st_ += NGW; \
        for (int it_ = st_; it_ < items_; it_ += NGW) p0_transpose_item((Wp), (gp), (K_), (N_), (bf16*)(ws + (WTo)), (roff), scr, it_, lane); off += items_; } while (0)
        const float* attn_norm = args.in[2]; const float* mlp_norm = args.in[3];
        for (int l = 0; l < 4; ++l) {
            CONV(args.in[14] + (size_t)l * D * FF, mlp_norm + l * D, D, FF, O_W1 + l * 8 * MB, 0);
            if (l != 2) CONV(args.in[15] + (size_t)l * FF * D, (const float*)nullptr, FF, D, O_W2 + l * 8 * MB, 0);
            else { CONV(args.in[15] + (size_t)l * FF * D, (const float*)nullptr, 2048, D, O_W2 + 16 * MB, 0);
                   CONV(args.in[15] + (size_t)l * FF * D + (size_t)2048 * D, (const float*)nullptr, 2048, D, O_W2 + 20 * MB, 0); }
        }
        for (int l = 0; l < 2; ++l) {
            CONV(args.in[4] + (size_t)l * D * 3072, attn_norm + l * D, D, 3072, O_WQKV + l * 6 * MB, 0);
            CONV(args.in[5] + (size_t)l * D * D, (const float*)nullptr, D, D, O_WOSB + l * 2 * MB, 0);
            CONV(args.in[12] + (size_t)l * 384 * 1536, args.in[11] + l * 384, 384, 1536, O_WUQ + l * 1152 * KB, 0);
            CONV(args.in[13] + (size_t)l * D * D, (const float*)nullptr, D, D, O_WOM + l * 2 * MB, 0);
        }
        CONV(args.in[7], args.in[6], D, 288, O_WD0, 0);
        CONV(args.in[10], attn_norm + 2 * D, D, 384, O_WD0, 288);
        CONV(args.in[10] + (size_t)D * 384, attn_norm + 3 * D, D, 384, O_WD1, 0);
        CONV(args.in[9], args.in[8], 256, 2048, O_WUKV, 0);
#undef CONV
        for (int i = gw * 64 + lane; i < 224 * 128; i += NGW * 64) { const int row = i >> 7, c16 = i & 127;
            bf16* dst = row < 96 ? (bf16*)(ws + O_WD0) + (size_t)(672 + row) * D : (bf16*)(ws + O_WD1) + (size_t)(384 + row - 96) * D;
            *(GAS v4u*)(dst + c16 * 8) = (v4u){0u, 0u, 0u, 0u}; }
        { const int* pos = (const int*)args.in[1]; float* CS = (float*)(ws + O_CS);
          for (int i = gw * 64 + lane; i < M * 16; i += NGW * 64) { const int m = i >> 4, k = i & 15;
              const double bs = (k & 3) == 0 ? 1.0 : (k & 3) == 1 ? 0.5623413251903491 : (k & 3) == 2 ? 0.31622776601683794 : 0.1778279410038923;
              const double sc = (k >> 2) == 0 ? 1.0 : (k >> 2) == 1 ? 0.1 : (k >> 2) == 2 ? 0.01 : 0.001;
              const float inv = (float)(bs * sc); const float ang = (float)pos[m] * inv;
              const double rev = (double)ang * 0.15915494309189535; const float fr = (float)(rev - __builtin_rint(rev));
              CS[m * 32 + k] = __builtin_amdgcn_cosf(fr); CS[m * 32 + 16 + k] = __builtin_amdgcn_sinf(fr); } }
        for (int m = gw; m < M; m += NGW) rms_row_to_bf16(args.in[0] + (size_t)m * D, (bf16*)(ws + O_XN) + (size_t)m * D, lane);
    }
    cg::this_grid().sync();

    const int lane0 = lane;
    for (int ph = 0; ph < NPH; ++ph) {
        const int op = prog[ph].op;
        int lane = lane0; asm volatile("" : "+v"(lane));
        if (op <= OP_GF32) {
#ifndef NO_GEMM
            pg8::Gemm g{(const bf16*)(ws + prog[ph].a), (const bf16*)(ws + prog[ph].b), M, prog[ph].N, prog[ph].K};
            pg8::StaticOrder S; S.init(M, prog[ph].N, G, bx);
            if (op == OP_GB) { pg8::EpiBf16<0> E{(bf16*)(ws + prog[ph].c), prog[ph].ldc, prog[ph].p0, (size_t)M * 1024, prog[ph].s0, prog[ph].s1};
                pg8::gemm_phase<pg8::EpiBf16<0>, pg8::StaticOrder, true, true>(L + RING_OFF, g, S, E); }
            else if (op == OP_GR2) { pg8::EpiBf16<2> E{(bf16*)(ws + prog[ph].c), prog[ph].ldc, 0, 0, 1.f, 1.f};
                pg8::gemm_phase<pg8::EpiBf16<2>, pg8::StaticOrder, true, true>(L + RING_OFF, g, S, E); }
            else if (op == OP_GRES) { pg8::EpiF32<true> E{prog[ph].p0 ? args.in[0] : X, X, prog[ph].ldc};
                pg8::gemm_phase<pg8::EpiF32<true>, pg8::StaticOrder, true, true>(L + RING_OFF, g, S, E); }
            else { pg8::EpiF32<false> E{nullptr, (float*)(ws + prog[ph].c), prog[ph].ldc};
                pg8::gemm_phase<pg8::EpiF32<false>, pg8::StaticOrder, true, true>(L + RING_OFF, g, S, E); }
#endif
        } else if (op == OP_ATTA) {
            att::ALAS_char_t wl = (att::ALAS_char_t)(L + RING_OFF + wave * 16384);
            att::SbConsts tc; att::sb_consts(tc, lane);
#ifndef NO_ATTA
            for (int u = gw; u < 32 * 256; u += NGW) { const int bh = u >> 8, qblk = u & 255;
                att::sb_unit(bh >> 4, bh & 15, qblk, (const bf16*)(ws + O_Q), (const bf16*)(ws + O_K), (const bf16*)(ws + O_V), (bf16*)(ws + O_Q), wl, tc); }
#endif
        } else if (op == OP_ATTB) {
#ifndef NO_ATTB
            for (int i = 0; ; ++i) { int bh, qb;
                if (G == 256) { if (i >= 4) break; const int s = vcu & 7; bh = vcu >> 3; qb = (i == 0) ? s : (i == 1) ? 15 - s : (i == 2) ? 16 + s : 31 - s; }
                else { const int id = vcu + i * G; if (id >= 1024) break; bh = id & 31; qb = 31 - (id >> 5); }
                att::mla_unit<8>(bh >> 4, bh & 15, qb, (const bf16*)(ws + O_QB), (const bf16*)(ws + O_KVB), (const bf16*)(ws + O_KR), (const float*)(ws + O_CS), (bf16*)(ws + O_OB), (att::ALAS_char_t)(L + RING_OFF)); }
#endif
        } else if (op == OP_NORM) {
            for (int m = gw; m < M; m += NGW) rms_row_to_bf16(X + (size_t)m * D, (bf16*)(ws + O_XN) + (size_t)m * D, lane);
        } else if (op == OP_LAT) {
            const int q_only = prog[ph].p0; const int ldq = q_only ? 512 : 768, qoff = q_only ? 0 : 288;
            const float* DQ = (const float*)(ws + O_DQ); const float* CS = (const float*)(ws + O_CS);
            for (int m = gw; m < M; m += NGW) { const float* row = DQ + (size_t)m * ldq;
                float q[6]; float s2 = 0.f;
#pragma unroll
                for (int j = 0; j < 6; ++j) { q[j] = row[qoff + j * 64 + lane]; s2 += q[j] * q[j]; }
                const float rq = 1.f / sqrtf(wave_sum(s2) * (1.f / 384.f) + NORM_EPS);
                bf16* cq = (bf16*)(ws + O_CQ) + (size_t)m * 384;
#pragma unroll
                for (int j = 0; j < 6; ++j) cq[j * 64 + lane] = (bf16)f2bf(q[j] * rq);
                if (!q_only) {
                    const f32x4 v = *((const GAS f32x4*)row + lane); const float sk = (v.x * v.x + v.y * v.y) + (v.z * v.z + v.w * v.w);
                    const float rk = 1.f / sqrtf(wave_sum(sk) * (1.f / 256.f) + NORM_EPS);
                    *((GAS unsigned long long*)((bf16*)(ws + O_CKV) + (size_t)m * 256) + lane) = (unsigned long long)pk2(v.x * rk, v.y * rk) | ((unsigned long long)pk2(v.z * rk, v.w * rk) << 32);
                    if (lane < 16) { const float t1 = row[256 + lane], t2 = row[272 + lane], c = CS[m * 32 + lane], s = CS[m * 32 + 16 + lane];
                        bf16* kr = (bf16*)(ws + O_KR) + (size_t)m * 32; kr[lane] = (bf16)f2bf(t1 * c - t2 * s); kr[16 + lane] = (bf16)f2bf(t2 * c + t1 * s); } } }
        } else {
            const float* gfin = args.in[16];
            for (int m = gw; m < M; m += NGW) { GAS f32x4* xr = (GAS f32x4*)(X + (size_t)m * D) + lane; f32x4 v[4]; float s2 = 0.f;
#pragma unroll
                for (int j = 0; j < 4; ++j) { v[j] = xr[64 * j]; s2 += (v[j].x * v[j].x + v[j].y * v[j].y) + (v[j].z * v[j].z + v[j].w * v[j].w); }
                const float r = 1.f / sqrtf(wave_sum(s2) * (1.f / D) + NORM_EPS);
#pragma unroll
                for (int j = 0; j < 4; ++j) { const f32x4 gg = *((const GAS f32x4*)gfin + lane + 64 * j); xr[64 * j] = v[j] * r * gg; } }
        }
        if (!prog[ph].nosync) xcd_barrier(bar);
    }
}

extern "C" void kernel_launch(void* const* d_in, const int* in_sizes, int n_in, void* d_out, int out_size, void* d_ws, size_t ws_size, hipStream_t stream) {
    static int grid = 0;
    if (grid == 0) {
        if (n_in != 17 || in_sizes[0] != M * D || out_size != M * D || ws_size < WS_NEED) { fprintf(stderr, "kernel_launch: unexpected shapes (n_in %d, out %d, ws %zu); nothing launched\n", n_in, out_size, ws_size); grid = -1; return; }
        int dev = 0, cus = 0, per_cu = 0;
        if (hipGetDevice(&dev) != hipSuccess || hipDeviceGetAttribute(&cus, hipDeviceAttributeMultiprocessorCount, dev) != hipSuccess) { grid = -1; return; }
        if (hipFuncSetAttribute((const void*)fwd, hipFuncAttributeMaxDynamicSharedMemorySize, LDS_BYTES) != hipSuccess) { fprintf(stderr, "kernel_launch: hipFuncSetAttribute failed\n"); grid = -1; return; }
        if (hipOccupancyMaxActiveBlocksPerMultiprocessor(&per_cu, (const void*)fwd, NWAVES * 64, LDS_BYTES) != hipSuccess || per_cu < 1) { fprintf(stderr, "kernel_launch: occupancy query says %d\n", per_cu); per_cu = 1; }
        (void)hipGetLastError();
        grid = cus;
    }
    if (grid < 0) return;
    (void)hipMemsetAsync((char*)d_ws + O_CTL, 0, CTL_ZERO_BYTES, stream);
    Args a{};
    for (int i = 0; i < 17; ++i) a.in[i] = (const float*)d_in[i];
    a.out = (float*)d_out; a.ws = (unsigned char*)d_ws;
    void* kargs[] = {&a};
    const hipError_t le = hipLaunchCooperativeKernel((const void*)fwd, dim3(grid), dim3(NWAVES * 64), kargs, LDS_BYTES, stream);
    if (le != hipSuccess) fprintf(stderr, "kernel_launch: cooperative launch failed: %s (grid %d)\n", hipGetErrorName(le), grid);
}
```

```cpp
#include <hip/hip_runtime.h>
#include <hip/hip_cooperative_groups.h>
#include <cstdio>
#include <cstdint>
namespace cg = cooperative_groups;
namespace pg8 {
#define PG8_LAS __attribute__((address_space(3)))
typedef unsigned short bf16_t;
typedef short bf16x8 __attribute__((ext_vector_type(8)));
typedef float f32x4 __attribute__((ext_vector_type(4)));
typedef unsigned u32x4 __attribute__((ext_vector_type(4)));
constexpr int BM = 256, BK = 64, HALF = 128, HTB = HALF * BK * 2  , STAGE_BYTES = 8 * HTB, NXCD = 8, WGM = 8;

__host__ __device__ __forceinline__ int lds_byte(int r, int c) { const int st = (r >> 4) * 2 + (c >> 5), rr = r & 15, cc = c & 31, ob = rr * 64 + cc * 2; return st * 1024 + (ob ^ (((ob >> 9) & 1) << 5)); }
__host__ __device__ __forceinline__ void stage_rc(int b, int& R, int& C) { const int st = b / 1024, sb = b % 1024, swz = sb ^ (((sb >> 9) & 1) << 5); R = (st >> 1) * 16 + swz / 64; C = (st & 1) * 32 + (swz % 64) / 2; }
__host__ __device__ __forceinline__ int perm32(int rho) { const int n = rho >> 4, i = rho & 15; return 8 * (i >> 2) + 4 * n + (i & 3); }

struct Unit { int pm, pn; };
struct Gemm { const bf16_t* A; const bf16_t* Bt; int M, N, K; };

struct StaticOrder {
    int nM, nN, nwg, G, c;
    __host__ __device__ void init(int M, int N, int G_, int c_) { nM = M / BM; nN = N / BM; nwg = nM * nN; G = G_; c = c_; }
    __host__ __device__ bool next(int i, Unit& u) const {
        const long L = (long)i * G + c; if (L >= nwg) return false;
        int wgid = (int)L; { const int q = nwg / NXCD, r = nwg % NXCD, xcd = wgid % NXCD, off = wgid / NXCD; wgid = (xcd < r ? xcd * (q + 1) : r * (q + 1) + (xcd - r) * q) + off; }
        const int nig = WGM * nN, gid = wgid / nig, fm = gid * WGM, gsz = (nM - fm) < WGM ? (nM - fm) : WGM;
        u.pm = fm + ((wgid % nig) % gsz); u.pn = (wgid % nig) / gsz; return true;
    }
    __device__ __forceinline__ void a_ready(const Unit&) const {}
    __device__ __forceinline__ void done(const Unit&) const {}
};

__device__ __forceinline__ unsigned cvt_pk_bf16(float lo, float hi) { unsigned r; asm volatile("v_cvt_pk_bf16_f32 %0, %1, %2" : "=v"(r) : "v"(lo), "v"(hi)); return r; }
typedef float f32x2 __attribute__((ext_vector_type(2)));
typedef unsigned long long rs_t;
__device__ __forceinline__ void rs_add(rs_t* p, float v) { __hip_atomic_fetch_add(p, (rs_t)(v * 16777216.f), __ATOMIC_RELAXED, __HIP_MEMORY_SCOPE_AGENT); }
__device__ __forceinline__ float rs_get(const rs_t* p) { return (float)(*p) * (1.f / 16777216.f); }
template <int ACT  > struct EpiBf16 {
    static constexpr bool PERM = true, AFTER_DRAIN = false;
    bf16_t* O; int ldc; int split_cols; size_t split_stride; float scale0, scale; const rs_t* rs; float rs_inv_n;
    __device__ __forceinline__ void operator()(const f32x4 (&acc)[2][2][4][2], const Unit& u, int wr, int wc, int fr, int fq) const {
        const int row0 = u.pm * BM + wr * 64 + fr; int colt = u.pn * BM; bf16_t* base = O;
        float sc = scale; if (split_cols) { const int t = colt / split_cols; base += (size_t)t * split_stride; colt -= t * split_cols; if (t == 0) sc *= scale0; }
        const int col0 = colt + wc * 32 + 8 * fq;
        float scv[2][4];
        if (rs) { rs_t rv[2][4];
#pragma unroll
            for (int ai = 0; ai < 2; ++ai)
#pragma unroll
                for (int m = 0; m < 4; ++m) rv[ai][m] = rs[row0 + ai * HALF + m * 16];
#pragma unroll
            for (int ai = 0; ai < 2; ++ai)
#pragma unroll
                for (int m = 0; m < 4; ++m) scv[ai][m] = sc * __builtin_amdgcn_rsqf((float)rv[ai][m] * (1.f / 16777216.f) * rs_inv_n + 1e-6f); }
        else {
#pragma unroll
            for (int ai = 0; ai < 2; ++ai)
#pragma unroll
                for (int m = 0; m < 4; ++m) scv[ai][m] = sc; }
#pragma unroll
        for (int ai = 0; ai < 2; ++ai)
#pragma unroll
            for (int m = 0; m < 4; ++m) { bf16_t* rowp = base + (size_t)(row0 + ai * HALF + m * 16) * ldc + col0;
                const float scr = scv[ai][m];
#pragma unroll
                for (int bj = 0; bj < 2; ++bj) { f32x4 v0 = acc[ai][bj][m][0], v1 = acc[ai][bj][m][1];
                    v0 = v0 * scr; v1 = v1 * scr;
                    if (ACT == 2) {
#pragma unroll
                        for (int e = 0; e < 4; ++e) { const float a = __builtin_fmaxf(v0[e], 0.f), b = __builtin_fmaxf(v1[e], 0.f); v0[e] = a * a; v1[e] = b * b; } }
                    u32x4 w; w.x = cvt_pk_bf16(v0[0], v0[1]); w.y = cvt_pk_bf16(v0[2], v0[3]); w.z = cvt_pk_bf16(v1[0], v1[1]); w.w = cvt_pk_bf16(v1[2], v1[3]);
                    *(u32x4*)(rowp + bj * HALF) = w; } }
    }
};
template <bool RES> struct EpiF32 {
    static constexpr bool PERM = true, AFTER_DRAIN = false;
    const float* base; float* out; int ldc; bf16_t* xn; rs_t* rs; const bf16_t* base16;
    __device__ __forceinline__ void emit(f32x4 o0, f32x4 o1, size_t off, float& ss) const {
        if (out) { *(f32x4*)(out + off) = o0; *(f32x4*)(out + off + 4) = o1; }
        if (RES && xn) { u32x4 w; w.x = cvt_pk_bf16(o0[0], o0[1]); w.y = cvt_pk_bf16(o0[2], o0[3]); w.z = cvt_pk_bf16(o1[0], o1[1]); w.w = cvt_pk_bf16(o1[2], o1[3]);
            *(u32x4*)(xn + off) = w;
            ss += ((o0[0] * o0[0] + o0[1] * o0[1]) + (o0[2] * o0[2] + o0[3] * o0[3])) + ((o1[0] * o1[0] + o1[1] * o1[1]) + (o1[2] * o1[2] + o1[3] * o1[3])); }
    }
    __device__ __forceinline__ void operator()(const f32x4 (&acc)[2][2][4][2], const Unit& u, int wr, int wc, int fr, int fq) const {
        const int col0 = u.pn * BM + wc * 32 + 8 * fq;
        if (RES && base16) {
#pragma unroll
            for (int ai = 0; ai < 2; ++ai) {
                u32x4 bw[4][2];
#pragma unroll
                for (int m = 0; m < 4; ++m)
#pragma unroll
                    for (int bj = 0; bj < 2; ++bj) bw[m][bj] = *(const u32x4*)(base16 + (size_t)(u.pm * BM + ai * HALF + wr * 64 + m * 16 + fr) * ldc + col0 + bj * HALF);
                asm volatile("s_waitcnt vmcnt(0)" : "+v"(bw[0][0]), "+v"(bw[0][1]), "+v"(bw[1][0]), "+v"(bw[1][1]), "+v"(bw[2][0]), "+v"(bw[2][1]), "+v"(bw[3][0]), "+v"(bw[3][1]) :: "memory");
#pragma unroll
                for (int m = 0; m < 4; ++m) { const int row = u.pm * BM + ai * HALF + wr * 64 + m * 16 + fr; const size_t off = (size_t)row * ldc + col0; float ss = 0.f;
#pragma unroll
                    for (int bj = 0; bj < 2; ++bj) { const u32x4 w = bw[m][bj];
                        const f32x4 o0 = acc[ai][bj][m][0] + (f32x4){__uint_as_float(w.x << 16), __uint_as_float(w.x & 0xffff0000u), __uint_as_float(w.y << 16), __uint_as_float(w.y & 0xffff0000u)};
                        const f32x4 o1 = acc[ai][bj][m][1] + (f32x4){__uint_as_float(w.z << 16), __uint_as_float(w.z & 0xffff0000u), __uint_as_float(w.w << 16), __uint_as_float(w.w & 0xffff0000u)};
                        emit(o0, o1, off + bj * HALF, ss); }
                    if (xn && rs) { ss += __shfl_xor(ss, 16); ss += __shfl_xor(ss, 32); if (fq == 0) rs_add(rs + row, ss); } } }
            return;
        }
#pragma unroll
        for (int ai = 0; ai < 2; ++ai)
#pragma unroll
            for (int m = 0; m < 4; ++m) { const int row = u.pm * BM + ai * HALF + wr * 64 + m * 16 + fr; const size_t off = (size_t)row * ldc + col0;
                float rsc = 1.f; if (!RES && rs) rsc = __builtin_amdgcn_rsqf(rs_get(rs + row) * (1.f / 1024.f) + 1e-6f);
                float ss = 0.f;
#pragma unroll
                for (int bj = 0; bj < 2; ++bj) { f32x4 o0 = acc[ai][bj][m][0], o1 = acc[ai][bj][m][1];
                    if (RES) { o0 = o0 + *(const f32x4*)(base + off + bj * HALF); o1 = o1 + *(const f32x4*)(base + off + bj * HALF + 4); }
                    else { o0 = o0 * rsc; o1 = o1 * rsc; }
                    emit(o0, o1, off + bj * HALF, ss); }
                if (RES && xn && rs) { ss += __shfl_xor(ss, 16); ss += __shfl_xor(ss, 32); if (fq == 0) rs_add(rs + row, ss); }
                asm volatile("" ::: "memory"); }
    }
};
struct EpiLat {
    static constexpr bool PERM = false, AFTER_DRAIN = false;
    const rs_t* rs_x; int qoff; bf16_t* ckv; bf16_t* kr; bf16_t* cq; rs_t* rsk; rs_t* rsq; const float* cs;
    __device__ __forceinline__ void operator()(const f32x4 (&acc)[2][2][4][2], const Unit& u, int wr, int wc, int fr, int fq) const {
        typedef unsigned u32x2v __attribute__((ext_vector_type(2)));
        const int colw = u.pn * BM + wc * 32;
        float rsv[2][4];
#pragma unroll
        for (int ai = 0; ai < 2; ++ai)
#pragma unroll
            for (int m = 0; m < 4; ++m) rsv[ai][m] = rs_get(rs_x + u.pm * BM + ai * HALF + wr * 64 + m * 16 + fr);
        if (qoff && colw == 256) {
#pragma unroll
            for (int ai = 0; ai < 2; ++ai)
#pragma unroll
                for (int m = 0; m < 4; ++m) { const int row = u.pm * BM + ai * HALF + wr * 64 + m * 16 + fr;
                    const float rsc = __builtin_amdgcn_rsqf(rsv[ai][m] * (1.f / 1024.f) + 1e-6f);
                    const f32x4 v0 = acc[ai][0][m][0] * rsc, v1 = acc[ai][0][m][1] * rsc;
                    const f32x4 c = *(const f32x4*)(cs + (size_t)row * 32 + 4 * fq), sn = *(const f32x4*)(cs + (size_t)row * 32 + 16 + 4 * fq);
                    const f32x4 a = v0 * c - v1 * sn, b = v1 * c + v0 * sn; u32x2v w;
                    w.x = cvt_pk_bf16(a[0], a[1]); w.y = cvt_pk_bf16(a[2], a[3]); *(u32x2v*)(kr + (size_t)row * 32 + 4 * fq) = w;
                    w.x = cvt_pk_bf16(b[0], b[1]); w.y = cvt_pk_bf16(b[2], b[3]); *(u32x2v*)(kr + (size_t)row * 32 + 16 + 4 * fq) = w; } }
#pragma unroll
        for (int ai = 0; ai < 2; ++ai)
#pragma unroll
            for (int m = 0; m < 4; ++m) { const int row = u.pm * BM + ai * HALF + wr * 64 + m * 16 + fr;
                const float rsc = __builtin_amdgcn_rsqf(rsv[ai][m] * (1.f / 1024.f) + 1e-6f);
                float sk = 0.f, sq = 0.f;
#pragma unroll
                for (int bj = 0; bj < 2; ++bj) { const int c32 = colw + bj * HALF;
                    const f32x4 v0 = acc[ai][bj][m][0] * rsc, v1 = acc[ai][bj][m][1] * rsc;
                    if (qoff && c32 < 256) {
                        u32x2v w; w.x = cvt_pk_bf16(v0[0], v0[1]); w.y = cvt_pk_bf16(v0[2], v0[3]); *(u32x2v*)(ckv + (size_t)row * 256 + c32 + 4 * fq) = w;
                        w.x = cvt_pk_bf16(v1[0], v1[1]); w.y = cvt_pk_bf16(v1[2], v1[3]); *(u32x2v*)(ckv + (size_t)row * 256 + c32 + 16 + 4 * fq) = w;
                        sk += (v0[0] * v0[0] + v0[1] * v0[1]) + (v0[2] * v0[2] + v0[3] * v0[3]) + (v1[0] * v1[0] + v1[1] * v1[1]) + (v1[2] * v1[2] + v1[3] * v1[3]);
                    } else if (qoff && c32 == 256) {
                    } else if (c32 >= qoff && c32 < qoff + 384) {
                        u32x2v w; w.x = cvt_pk_bf16(v0[0], v0[1]); w.y = cvt_pk_bf16(v0[2], v0[3]); *(u32x2v*)(cq + (size_t)row * 384 + (c32 - qoff) + 4 * fq) = w;
                        w.x = cvt_pk_bf16(v1[0], v1[1]); w.y = cvt_pk_bf16(v1[2], v1[3]); *(u32x2v*)(cq + (size_t)row * 384 + (c32 - qoff) + 16 + 4 * fq) = w;
                        sq += (v0[0] * v0[0] + v0[1] * v0[1]) + (v0[2] * v0[2] + v0[3] * v0[3]) + (v1[0] * v1[0] + v1[1] * v1[1]) + (v1[2] * v1[2] + v1[3] * v1[3]);
                    } }
                sk += __shfl_xor(sk, 16); sk += __shfl_xor(sk, 32); sq += __shfl_xor(sq, 16); sq += __shfl_xor(sq, 32);
                if (fq == 0) { if (qoff && colw < 256) rs_add(rsk + row, sk);
                               if (colw + HALF + 32 > qoff && colw < qoff + 384) rs_add(rsq + row, sq); }
                asm volatile("" ::: "memory"); }
    }
};
template <class Epi, class Sched, bool ALIGN_EPI = false, bool SP2 = false>
__device__ __forceinline__ void gemm_phase(PG8_LAS unsigned char* lds, const Gemm g, const Sched& S, const Epi& E) {
    int tid_ = threadIdx.x; asm volatile("" : "+v"(tid_));
    const int tid = tid_, wid = __builtin_amdgcn_readfirstlane(tid >> 6), lane = tid & 63, wr = wid >> 2, wc = wid & 3, fr = lane & 15, fq = lane >> 4;
    const int K = g.K, nt = K / BK;
    unsigned voffA[2], voffB[2];
#pragma unroll
    for (int i = 0; i < 2; ++i) { int R, C; stage_rc(tid * 16 + i * 8192, R, C); const int Rb = Epi::PERM ? ((R & ~31) + perm32(R & 31)) : R;
        voffA[i] = (unsigned)(R * K + C) * 2u; voffB[i] = (unsigned)(Rb * K + C) * 2u; }
    const size_t kstep = (size_t)(BK * 2);
    const size_t hstep = (size_t)HALF * K * 2;
    const size_t tstep = 2 * hstep;
    const unsigned ldsw = (unsigned)wid * 1024u;
    const int aoff = lds_byte(wr * 64 + fr, fq * 8), boff = lds_byte(wc * 32 + fr, fq * 8);
#define PG8_SA(b, h) (((b) * 2 + (h)) * HTB)
#define PG8_SB(b, h) ((4 + (b) * 2 + (h)) * HTB)
#define PG8_STAGE(bufoff, gbase, voff) do { _Pragma("unroll") for (int _i = 0; _i < 2; ++_i) \
        __builtin_amdgcn_global_load_lds((const unsigned*)((const char*)(gbase) + (voff)[_i]), (PG8_LAS unsigned*)(lds + (bufoff) + ldsw + _i * 8192), 16, 0, 0); } while (0)
#define PG8_LDA(dst, b, h) do { _Pragma("unroll") for (int m = 0; m < 4; ++m) _Pragma("unroll") for (int k = 0; k < 2; ++k) dst[m][k] = *(const PG8_LAS bf16x8*)(lds + PG8_SA(b, h) + aoff + m * 2048 + k * 1024); } while (0)
#define PG8_LDB(dst, b, h) do { _Pragma("unroll") for (int n = 0; n < 2; ++n) _Pragma("unroll") for (int k = 0; k < 2; ++k) dst[n][k] = *(const PG8_LAS bf16x8*)(lds + PG8_SB(b, h) + boff + n * 2048 + k * 1024); } while (0)
#define PG8_MMA(ai, bj, At, Bt) do { __builtin_amdgcn_s_setprio(1); _Pragma("unroll") for (int m = 0; m < 4; ++m) _Pragma("unroll") for (int n = 0; n < 2; ++n) _Pragma("unroll") for (int k = 0; k < 2; ++k) \
        acc[ai][bj][m][n] = __builtin_amdgcn_mfma_f32_16x16x32_bf16(Bt[n][k], At[m][k], acc[ai][bj][m][n], 0, 0, 0); __builtin_amdgcn_s_setprio(0); } while (0)
#define PG8_WAIT_V(n) asm volatile("s_waitcnt vmcnt(" #n ")" ::: "memory")
#define PG8_WAIT_L(n) asm volatile("s_waitcnt lgkmcnt(" #n ")" ::: "memory")
#define PG8_BAR __builtin_amdgcn_s_barrier()
#define PG8_SCHED __builtin_amdgcn_sched_barrier(0)
    Unit cur, nxt; int ui = 0;
    if (!S.next(0, cur)) return;
    f32x4 acc[2][2][4][2];
#pragma unroll
    for (int a = 0; a < 2; ++a)
#pragma unroll
        for (int b = 0; b < 2; ++b)
#pragma unroll
            for (int m = 0; m < 4; ++m)
#pragma unroll
                for (int n = 0; n < 2; ++n) acc[a][b][m][n] = (f32x4){0.f, 0.f, 0.f, 0.f};
    bf16x8 At[4][2], B0[2][2], B1[2][2];
    const char* cA = (const char*)g.A + (size_t)cur.pm * tstep; const char* cB = (const char*)g.Bt + (size_t)cur.pn * tstep;
    S.a_ready(cur);
    if constexpr (SP2) {
        PG8_STAGE(PG8_SB(0, 0), cB, voffB); PG8_STAGE(PG8_SB(0, 1), cB + hstep, voffB); PG8_STAGE(PG8_SA(0, 0), cA, voffA); PG8_STAGE(PG8_SA(0, 1), cA + hstep, voffA);
        if (wr == 1) PG8_BAR;
        PG8_WAIT_V(2); PG8_BAR;
        PG8_STAGE(PG8_SB(1, 0), cB + kstep, voffB); PG8_STAGE(PG8_SA(1, 0), cA + kstep, voffA); PG8_STAGE(PG8_SB(1, 1), cB + hstep + kstep, voffB);
        PG8_WAIT_V(6); PG8_BAR;
    } else {
        PG8_STAGE(PG8_SB(0, 0), cB, voffB); PG8_STAGE(PG8_SA(0, 0), cA, voffA); PG8_STAGE(PG8_SB(0, 1), cB + hstep, voffB); PG8_STAGE(PG8_SA(0, 1), cA + hstep, voffA);
        if (wr == 1) PG8_BAR;
        PG8_WAIT_V(4); PG8_BAR;
        PG8_STAGE(PG8_SB(1, 0), cB + kstep, voffB); PG8_STAGE(PG8_SA(1, 0), cA + kstep, voffA); PG8_STAGE(PG8_SB(1, 1), cB + hstep + kstep, voffB);
        PG8_WAIT_V(6); PG8_BAR;
    }
    for (;;) {
        const bool has_next = S.next(ui + 1, nxt);
        const char* nA = has_next ? (const char*)g.A + (size_t)nxt.pm * tstep : cA; const char* nB = has_next ? (const char*)g.Bt + (size_t)nxt.pn * tstep : cB;
        for (int t = 0; t < nt; t += 2) {
            const bool last = (t == nt - 2);
            const char* a1 = cA + (size_t)(t + 1) * kstep;
            const char* a2 = last ? nA : cA + (size_t)(t + 2) * kstep; const char* b2 = last ? nB : cB + (size_t)(t + 2) * kstep;
            const char* a3 = a2 + kstep; const char* b3 = b2 + kstep;
            if (last && has_next) S.a_ready(nxt);
            if constexpr (SP2) {
            PG8_LDB(B0, 0, 0); PG8_LDB(B1, 0, 1); PG8_SCHED; PG8_LDA(At, 0, 0); PG8_STAGE(PG8_SA(1, 1), a1 + hstep, voffA);
            PG8_WAIT_V(8); PG8_WAIT_L(0); PG8_BAR; PG8_MMA(0, 0, At, B0); PG8_MMA(0, 1, At, B1); PG8_BAR; PG8_SCHED;
            PG8_LDA(At, 0, 1); PG8_STAGE(PG8_SB(0, 0), b2, voffB); PG8_STAGE(PG8_SB(0, 1), b2 + hstep, voffB); PG8_STAGE(PG8_SA(0, 0), a2, voffA);
            PG8_WAIT_V(8); PG8_WAIT_L(0); PG8_BAR; PG8_MMA(1, 0, At, B0); PG8_MMA(1, 1, At, B1); PG8_BAR; PG8_SCHED;
            PG8_LDB(B0, 1, 0); PG8_LDB(B1, 1, 1); PG8_SCHED; PG8_LDA(At, 1, 0); PG8_STAGE(PG8_SA(0, 1), a2 + hstep, voffA);
            PG8_WAIT_V(8); PG8_WAIT_L(0); PG8_BAR; PG8_MMA(0, 0, At, B0); PG8_MMA(0, 1, At, B1); PG8_BAR; PG8_SCHED;
            PG8_LDA(At, 1, 1); PG8_STAGE(PG8_SB(1, 0), b3, voffB); PG8_STAGE(PG8_SB(1, 1), b3 + hstep, voffB); PG8_STAGE(PG8_SA(1, 0), a3, voffA);
            PG8_WAIT_V(8); PG8_WAIT_L(0); PG8_BAR; PG8_MMA(1, 0, At, B0); PG8_MMA(1, 1, At, B1); PG8_BAR; PG8_SCHED;
            } else {
            PG8_LDB(B0, 0, 0); PG8_SCHED; PG8_LDA(At, 0, 0); PG8_STAGE(PG8_SA(1, 1), a1 + hstep, voffA);
            PG8_WAIT_L(8); PG8_BAR; PG8_WAIT_L(0); PG8_MMA(0, 0, At, B0); PG8_BAR; PG8_SCHED;
            PG8_LDB(B1, 0, 1); PG8_STAGE(PG8_SB(0, 0), b2, voffB);
            PG8_BAR; PG8_WAIT_L(0); PG8_MMA(0, 1, At, B1); PG8_BAR;
            PG8_LDA(At, 0, 1); PG8_STAGE(PG8_SA(0, 0), a2, voffA);
            PG8_BAR; PG8_WAIT_L(0); PG8_MMA(1, 0, At, B0); PG8_BAR; PG8_SCHED;
            PG8_STAGE(PG8_SB(0, 1), b2 + hstep, voffB);
            PG8_WAIT_V(6); PG8_BAR; PG8_MMA(1, 1, At, B1); PG8_BAR;
            PG8_LDB(B0, 1, 0); PG8_SCHED; PG8_LDA(At, 1, 0); PG8_STAGE(PG8_SA(0, 1), a2 + hstep, voffA);
            PG8_WAIT_L(8); PG8_BAR; PG8_WAIT_L(0); PG8_MMA(0, 0, At, B0); PG8_BAR; PG8_SCHED;
            PG8_LDB(B1, 1, 1); PG8_STAGE(PG8_SB(1, 0), b3, voffB);
            PG8_BAR; PG8_WAIT_L(0); PG8_MMA(0, 1, At, B1); PG8_BAR;
            PG8_LDA(At, 1, 1); PG8_STAGE(PG8_SA(1, 0), a3, voffA);
            PG8_BAR; PG8_WAIT_L(0); PG8_MMA(1, 0, At, B0); PG8_BAR; PG8_SCHED;
            PG8_STAGE(PG8_SB(1, 1), b3 + hstep, voffB);
            PG8_WAIT_V(6); PG8_BAR; PG8_MMA(1, 1, At, B1); PG8_BAR;
            }
        }
        if constexpr (ALIGN_EPI) { if (wr == 0) PG8_BAR; }
        if constexpr (!Epi::AFTER_DRAIN) { E(acc, cur, wr, wc, fr, fq); S.done(cur); }
        if (!has_next) break;
#pragma unroll
        for (int a = 0; a < 2; ++a)
#pragma unroll
            for (int b = 0; b < 2; ++b)
#pragma unroll
                for (int m = 0; m < 4; ++m)
#pragma unroll
                    for (int n = 0; n < 2; ++n) acc[a][b][m][n] = (f32x4){0.f, 0.f, 0.f, 0.f};
        cur = nxt; cA = nA; cB = nB; ++ui;
        if constexpr (ALIGN_EPI) { if (wr == 1) PG8_BAR; }
    }
    PG8_WAIT_V(0);
    if constexpr (!ALIGN_EPI) { if (wr == 0) PG8_BAR; }
    PG8_BAR;
    if constexpr (Epi::AFTER_DRAIN) { E.fused(acc, cur, wr, wc, fr, fq, lds, wid, lane); S.done(cur); }
#undef PG8_SA
#undef PG8_SB
#undef PG8_STAGE
#undef PG8_LDA
#undef PG8_LDB
#undef PG8_MMA
#undef PG8_WAIT_V
#undef PG8_WAIT_L
#undef PG8_BAR
#undef PG8_SCHED
}
}
namespace att {
#define ALAS __attribute__((address_space(3)))
typedef unsigned short bf16_t;
typedef short bf16x8 __attribute__((ext_vector_type(8)));
typedef short s16x4 __attribute__((ext_vector_type(4)));
typedef float f32x16 __attribute__((ext_vector_type(16)));
typedef float f32x4 __attribute__((ext_vector_type(4)));
typedef unsigned u32x4 __attribute__((ext_vector_type(4)));
typedef float f32x2_t __attribute__((ext_vector_type(2))); typedef __bf16 bf16x2_t __attribute__((ext_vector_type(2)));
constexpr int SEQ = 8192;
typedef ALAS char* ALAS_char_t;
__device__ __forceinline__ int crow(int r, int hi) { return (r & 3) + 8 * (r >> 2) + 4 * hi; }
#define SBAR() __builtin_amdgcn_sched_barrier(0)
__device__ __forceinline__ void glds16(const void* gsrc, unsigned lds_dst) { unsigned keep;
  asm volatile("s_mov_b32 %0, m0\n\ts_mov_b32 m0, %2\n\ts_nop 0\n\tglobal_load_lds_dwordx4 %1, off\n\ts_mov_b32 m0, %0" : "=&s"(keep) : "v"(gsrc), "s"(lds_dst) : "memory"); }
__device__ __forceinline__ unsigned cvtpk_s(float lo, float hi) { f32x2_t v = {lo, hi}; bf16x2_t b = __builtin_convertvector(v, bf16x2_t); return __builtin_bit_cast(unsigned, b); }
__device__ __forceinline__ float bf2f(short v) { return __uint_as_float(((unsigned)(unsigned short)v) << 16); }
__device__ __forceinline__ unsigned short f2bf(float f) { unsigned u = __builtin_bit_cast(unsigned, f); return (unsigned short)((u + 0x7fffu + ((u >> 16) & 1u)) >> 16); }
#define MFMA32(a, b, c) __builtin_amdgcn_mfma_f32_32x32x16_bf16((a), (b), (c), 0, 0, 0)
template <int NK> __device__ __forceinline__ void qkt(f32x16& p0, f32x16& p1, const ALAS char* kb, const bf16x8* qr, const f32x16& cinit) {
#pragma unroll
  for (int d0 = 0; d0 < NK; ++d0) {
    const bf16x8 b0 = *(const ALAS bf16x8*)(kb + d0 * 2048);
    const bf16x8 b1 = *(const ALAS bf16x8*)(kb + d0 * 2048 + 512);
    if (d0 == 0) { p0 = MFMA32(b0, qr[0], cinit); p1 = MFMA32(b1, qr[0], cinit); }
    else { p0 = MFMA32(b0, qr[d0], p0); p1 = MFMA32(b1, qr[d0], p1); } }
}
__device__ __forceinline__ void pv(f32x16* o, int vb, bf16x8 pa0, bf16x8 pa1, bf16x8 pa2, bf16x8 pa3) {
#pragma unroll
  for (int d0 = 0; d0 < 2; ++d0) { s16x4 lo[4], hi[4];
#pragma unroll
    for (int ks = 0; ks < 4; ++ks) {
      asm volatile("ds_read_b64_tr_b16 %0,%1 offset:%c2" : "=&v"(lo[ks]) : "v"(vb), "i"(d0 * 4096 + ks * 1024) : "memory");
      asm volatile("ds_read_b64_tr_b16 %0,%1 offset:%c2" : "=&v"(hi[ks]) : "v"(vb), "i"(d0 * 4096 + ks * 1024 + 512) : "memory"); }
    asm volatile("s_waitcnt lgkmcnt(0)" ::: "memory"); SBAR();
#define PK(k) (bf16x8){lo[k][0], lo[k][1], lo[k][2], lo[k][3], hi[k][0], hi[k][1], hi[k][2], hi[k][3]}
    o[d0] = MFMA32(pa0, PK(0), o[d0]); o[d0] = MFMA32(pa1, PK(1), o[d0]); o[d0] = MFMA32(pa2, PK(2), o[d0]); o[d0] = MFMA32(pa3, PK(3), o[d0]);
#undef PK
  }
}
__device__ __forceinline__ void pv2(f32x16* o, int vA, int vB, bf16x8 pa0, bf16x8 pa1, bf16x8 pa2, bf16x8 pa3) {
#pragma unroll
  for (int d0 = 0; d0 < 2; ++d0) { s16x4 lo[4], hi[4]; const int vb = d0 ? vB : vA;
#pragma unroll
    for (int ks = 0; ks < 4; ++ks) {
      asm volatile("ds_read_b64_tr_b16 %0,%1 offset:%c2" : "=&v"(lo[ks]) : "v"(vb), "i"(ks * 2048) : "memory");
      asm volatile("ds_read_b64_tr_b16 %0,%1 offset:%c2" : "=&v"(hi[ks]) : "v"(vb), "i"(ks * 2048 + 1024) : "memory"); }
    asm volatile("s_waitcnt lgkmcnt(0)" ::: "memory"); SBAR();
#define PK(k) (bf16x8){lo[k][0], lo[k][1], lo[k][2], lo[k][3], hi[k][0], hi[k][1], hi[k][2], hi[k][3]}
    o[d0] = MFMA32(pa0, PK(0), o[d0]); o[d0] = MFMA32(pa1, PK(1), o[d0]); o[d0] = MFMA32(pa2, PK(2), o[d0]); o[d0] = MFMA32(pa3, PK(3), o[d0]);
#undef PK
  }
}
__device__ __forceinline__ float rowmax(const f32x16& p0, const f32x16& p1) {
  float a = __builtin_fmaxf(p0[0], p1[0]), b = __builtin_fmaxf(p0[1], p1[1]);
#pragma unroll
  for (int r = 2; r < 16; r += 2) { a = __builtin_fmaxf(a, __builtin_fmaxf(p0[r], p1[r])); b = __builtin_fmaxf(b, __builtin_fmaxf(p0[r + 1], p1[r + 1])); }
  const float m = __builtin_fmaxf(a, b);
  auto rr = __builtin_amdgcn_permlane32_swap(__float_as_uint(m), __float_as_uint(m), false, false);
  return __builtin_fmaxf(__uint_as_float(rr[0]), __uint_as_float(rr[1]));
}
__device__ __forceinline__ float max3a(float a, float b, float c) { float r; asm("v_max3_f32 %0, %1, %2, %3" : "=v"(r) : "v"(a), "v"(b), "v"(c)); return r; }
__device__ __forceinline__ float max16a(const f32x16& p) { float a, b;
  asm("v_max3_f32 %0, %2, %3, %4\n\tv_max3_f32 %1, %5, %6, %7\n\tv_max3_f32 %0, %0, %8, %9\n\tv_max3_f32 %1, %1, %10, %11\n\tv_max3_f32 %0, %0, %12, %13\n\tv_max3_f32 %1, %1, %14, %15\n\tv_max3_f32 %0, %0, %16, %17\n\tv_max_f32_e32 %0, %0, %1"
      : "=&v"(a), "=&v"(b) : "v"(p[0]), "v"(p[1]), "v"(p[2]), "v"(p[3]), "v"(p[4]), "v"(p[5]), "v"(p[6]), "v"(p[7]), "v"(p[8]), "v"(p[9]), "v"(p[10]), "v"(p[11]), "v"(p[12]), "v"(p[13]), "v"(p[14]), "v"(p[15]));
  return a; }
__device__ __forceinline__ float rowmax_a(const f32x16& p0, const f32x16& p1) {
  const float a = max16a(p0), b = max16a(p1); float m; asm("v_max_f32_e32 %0, %1, %2" : "=v"(m) : "v"(a), "v"(b));
  auto rr = __builtin_amdgcn_permlane32_swap(__float_as_uint(m), __float_as_uint(m), false, false);
  float q; { const float x = __uint_as_float(rr[0]), y = __uint_as_float(rr[1]); asm("v_max_f32_e32 %0, %1, %2" : "=v"(q) : "v"(x), "v"(y)); }
  return q;
}
#define PKW(P, B) cvtpk_s(P[B], P[B + 1])
__device__ __forceinline__ void store_o(const f32x16* o, bf16_t* Ow, int pitch, ALAS bf16_t* stg, int lane) {
  const int r32 = lane & 31, hi = lane >> 5;
#pragma unroll
  for (int r = 0; r < 16; ++r) { const int orow = crow(r, hi);
#pragma unroll
    for (int d0 = 0; d0 < 2; ++d0) stg[orow * 64 + d0 * 32 + r32] = f2bf(o[d0][r]); }
  asm volatile("s_waitcnt lgkmcnt(0)" ::: "memory");
#pragma unroll
  for (int i = 0; i < 4; ++i) { const int row = i * 8 + (lane >> 3), ch = lane & 7; const u32x4 v = *(const ALAS u32x4*)(stg + row * 64 + ch * 8); *(u32x4*)(Ow + (long)row * pitch + ch * 8) = v; }
  asm volatile("s_waitcnt lgkmcnt(0)" ::: "memory");
}

struct SbConsts { bf16x8 T0, T1, ONES; };
__device__ __forceinline__ void sb_consts(SbConsts& c, int lane) {
  const int r = lane & 31, h = lane >> 5;
#pragma unroll
  for (int j = 0; j < 8; ++j) { const int kin = 8 * (j >> 2) + 4 * h + (j & 3); c.T0[j] = (kin > r) ? (short)0xBF80 : (short)0; c.T1[j] = (16 + kin > r) ? (short)0xBF80 : (short)0; c.ONES[j] = (short)0xBF80; }
}
__device__ __forceinline__ void sb_unit(int b, int h, int qblk, const bf16_t* Q, const bf16_t* __restrict__ K, const bf16_t* __restrict__ V, bf16_t* O, ALAS char* wl, const SbConsts& tc) {
  int tid_ = threadIdx.x; asm volatile("" : "+v"(tid_));
  const int lane = tid_ & 63, r32 = lane & 31, hi = lane >> 5;
  const long rowbase = (long)b * SEQ; const int q0 = qblk * 32;
  const bf16_t* Qw = Q + (rowbase + q0) * 1024 + h * 64;
  const bf16_t* Kh = K + rowbase * 1024 + h * 64; const bf16_t* Vh = V + rowbase * 1024 + h * 64;
  const unsigned kslot = (unsigned)__builtin_amdgcn_readfirstlane((int)(unsigned)(uintptr_t)wl), vslot = kslot + 8192u;
  bf16x8 qr[4];
#pragma unroll
  for (int d0 = 0; d0 < 4; ++d0) qr[d0] = *(const bf16x8*)(Qw + (long)r32 * 1024 + d0 * 16 + hi * 8);
  f32x16 o[2]; o[0] = f32x16{}; o[1] = f32x16{}; float C = 0.f;
  const ALAS char* kp = wl + r32 * 128; const int kg = (r32 >> 1) & 7;
  const int vq = (lane & 15) >> 2;
  const int vbA = (int)vslot + (4 * hi + vq) * 128 + ((vq >> 1) & 1) * 64 + ((lane >> 4) & 1) * 32 + (lane & 3) * 8, vbB = vbA ^ 64;
  const int tdiag = q0 >> 6;
  for (int t = tdiag; t >= 0; --t) {
    { const bf16_t* ks = Kh + (long)(64 * t + (lane >> 3)) * 1024;
#pragma unroll
      for (int p = 0; p < 8; ++p) glds16(ks + (long)(8 * p) * 1024 + (((lane & 7) ^ ((4 * p + (lane >> 4)) & 7)) * 8), kslot + p * 1024);
      const bf16_t* vs = Vh + (long)(64 * t + (lane >> 3)) * 1024 + (((lane & 7) ^ (((lane >> 4) & 1) << 2)) * 8);
#pragma unroll
      for (int p = 0; p < 8; ++p) glds16(vs + (long)(8 * p) * 1024, vslot + p * 1024); }
    asm volatile("s_waitcnt vmcnt(0)" ::: "memory");
    f32x16 y0, y1;
    { const f32x16 z = f32x16{}; bf16x8 kf[8];
#pragma unroll
      for (int d0 = 0; d0 < 4; ++d0) { const int off = ((2 * d0 + hi) ^ kg) << 4; kf[2 * d0] = *(const ALAS bf16x8*)(kp + off); kf[2 * d0 + 1] = *(const ALAS bf16x8*)(kp + off + 4096); }
      SBAR();
#pragma unroll
      for (int d0 = 0; d0 < 4; ++d0) {
        if (d0 == 0) { y0 = MFMA32(kf[0], qr[0], z); y1 = MFMA32(kf[1], qr[0], z); } else { y0 = MFMA32(kf[2 * d0], qr[d0], y0); y1 = MFMA32(kf[2 * d0 + 1], qr[d0], y1); } } }
    if (t == tdiag) { const int qrel = (q0 & 63) + r32;
      asm volatile("" : "+v"(y0), "+v"(y1));
#pragma unroll
      for (int r = 0; r < 16; ++r) { const int kv = 4 * hi + (r & 3) + 8 * (r >> 2); if (kv >= qrel) y0[r] = -1e30f; if (kv + 32 >= qrel) y1[r] = -1e30f; } }
    f32x16 L0, L1;
#pragma unroll
    for (int r = 0; r < 16; ++r) { y0[r] = __builtin_amdgcn_fmed3f(y0[r], -3.0e38f, 64.f); y1[r] = __builtin_amdgcn_fmed3f(y1[r], -3.0e38f, 64.f); }
    SBAR();
#pragma unroll
    for (int r = 0; r < 16; ++r) { L0[r] = __builtin_amdgcn_exp2f(y0[r]); L1[r] = __builtin_amdgcn_exp2f(y1[r]); }
    SBAR();
#pragma unroll
    for (int r = 0; r < 16; ++r) { L0[r] = 1.f + L0[r]; L1[r] = 1.f + L1[r]; }
    SBAR();
#pragma unroll
    for (int r = 0; r < 16; ++r) { L0[r] = __builtin_amdgcn_logf(L0[r]); L1[r] = __builtin_amdgcn_logf(L1[r]); }
    SBAR();
#pragma unroll
    for (int r = 0; r < 16; ++r) { y0[r] = y0[r] - L0[r]; y1[r] = y1[r] - L1[r]; }
    SBAR();
    u32x4 w0, w1, w2, w3;
    w0 = (u32x4){PKW(L0, 0), PKW(L0, 2), PKW(L0, 4), PKW(L0, 6)}; w1 = (u32x4){PKW(L0, 8), PKW(L0, 10), PKW(L0, 12), PKW(L0, 14)};
    w2 = (u32x4){PKW(L1, 0), PKW(L1, 2), PKW(L1, 4), PKW(L1, 6)}; w3 = (u32x4){PKW(L1, 8), PKW(L1, 10), PKW(L1, 12), PKW(L1, 14)};
    f32x16 cv;
#pragma unroll
    for (int r = 0; r < 16; ++r) cv[r] = C;
    f32x16 S0 = MFMA32(tc.T0, __builtin_bit_cast(bf16x8, w0), cv); S0 = MFMA32(tc.T1, __builtin_bit_cast(bf16x8, w1), S0);
    S0 = MFMA32(tc.ONES, __builtin_bit_cast(bf16x8, w2), S0); S0 = MFMA32(tc.ONES, __builtin_bit_cast(bf16x8, w3), S0);
    f32x16 S1 = MFMA32(tc.T0, __builtin_bit_cast(bf16x8, w2), cv); S1 = MFMA32(tc.T1, __builtin_bit_cast(bf16x8, w3), S1);
#pragma unroll
    for (int r = 0; r < 16; ++r) { y0[r] = y0[r] + S0[r]; y1[r] = y1[r] + S1[r]; }
    SBAR();
#pragma unroll
    for (int r = 0; r < 16; ++r) { y0[r] = __builtin_amdgcn_exp2f(y0[r]); y1[r] = __builtin_amdgcn_exp2f(y1[r]); }
    SBAR();
    { const float tot = S0[0] - L0[0]; auto rr = __builtin_amdgcn_permlane32_swap(__float_as_uint(tot), __float_as_uint(tot), false, false); C = __uint_as_float(rr[0]); }
    w0 = (u32x4){PKW(y0, 0), PKW(y0, 2), PKW(y0, 4), PKW(y0, 6)}; w1 = (u32x4){PKW(y0, 8), PKW(y0, 10), PKW(y0, 12), PKW(y0, 14)};
    w2 = (u32x4){PKW(y1, 0), PKW(y1, 2), PKW(y1, 4), PKW(y1, 6)}; w3 = (u32x4){PKW(y1, 8), PKW(y1, 10), PKW(y1, 12), PKW(y1, 14)};
    SBAR(); pv2(o, vbA, vbB, __builtin_bit_cast(bf16x8, w0), __builtin_bit_cast(bf16x8, w1), __builtin_bit_cast(bf16x8, w2), __builtin_bit_cast(bf16x8, w3));
    if (__all(C < -151.f)) break;
  }
  store_o(o, O + (rowbase + q0) * 1024 + h * 64, 1024, (ALAS bf16_t*)wl, lane);
}

constexpr int KSLOT = 12288, VSLOT = 8192, NSLOT = 3;
constexpr int LDS_K = 0, LDS_V = NSLOT * KSLOT, LDS_WS = LDS_V + NSLOT * VSLOT, LDS_OST = LDS_WS + 8 * 64 * 4, LDS_BYTES = LDS_OST + 8 * 4096;
#define WAIT_BAR(N) asm volatile("s_waitcnt vmcnt(" #N ") lgkmcnt(0)\n\ts_barrier" ::: "memory")
template <int THRL> __device__ __forceinline__ void mla_unit(int b, int h, int qb, const bf16_t* QB, const bf16_t* __restrict__ KVB, const bf16_t* __restrict__ KR, const float* __restrict__ CS, bf16_t* O, ALAS char* shm) {
  int tid_ = threadIdx.x; asm volatile("" : "+v"(tid_));
  const int tid = tid_, lane = tid & 63, r32 = lane & 31, hi = lane >> 5; const int wid = __builtin_amdgcn_readfirstlane(tid >> 6);
  const long rowbase = (long)b * SEQ; const int q0 = qb * 256;
  const unsigned lds0 = (unsigned)(uintptr_t)shm;
  ALAS float* wsf = (ALAS float*)(shm + LDS_WS) + wid * 64;
  const int NT = (q0 + 256) / 64;
  const long qrow = rowbase + q0 + wid * 32 + r32;
  bf16x8 qr[6];
  { const bf16_t* Qw = QB + qrow * 1536 + h * 96;
#pragma unroll
    for (int d0 = 0; d0 < 6; ++d0) qr[d0] = *(const bf16x8*)(Qw + d0 * 16 + hi * 8);
    const float* cs = CS + qrow * 32 + 8 * hi;
    const f32x4 c0 = *(const f32x4*)(cs), c1 = *(const f32x4*)(cs + 4), s0 = *(const f32x4*)(cs + 16), s1 = *(const f32x4*)(cs + 20);
#pragma unroll
    for (int j = 0; j < 8; ++j) { const float c = j < 4 ? c0[j & 3] : c1[j & 3], s = j < 4 ? s0[j & 3] : s1[j & 3];
      const float t1 = bf2f(qr[4][j]), t2 = bf2f(qr[5][j]); qr[4][j] = (short)f2bf(t1 * c - t2 * s); qr[5][j] = (short)f2bf(t2 * c + t1 * s); } }
  const bf16_t* ksrc = KVB + (rowbase + 8 * wid + (lane >> 3)) * 2048 + h * 128 + (((lane & 7) ^ ((4 * wid + (lane >> 4)) & 7)) * 8);
  const bf16_t* rsrc = KR + (rowbase + 16 * (wid & 3) + (lane >> 2)) * 32 + (((lane & 3) ^ ((lane >> 4) & 3)) * 8);
  const bf16_t* vsrc = KVB + (rowbase + 8 * wid + (lane >> 3)) * 2048 + h * 128 + 64 + (((lane & 7) ^ (((lane >> 4) & 1) << 2)) * 8);
  const unsigned kdst = lds0 + LDS_K + wid * 1024, rdst = lds0 + LDS_K + 8192 + (wid & 3) * 1024, vdst = lds0 + LDS_V + wid * 1024;
  const bool ropew = wid < 4;
#define DMA(t, s) do { glds16(ksrc + (long)(t) * 64 * 2048, (unsigned)__builtin_amdgcn_readfirstlane((int)(kdst + (s) * KSLOT))); \
    if (ropew) glds16(rsrc + (long)(t) * 64 * 32, (unsigned)__builtin_amdgcn_readfirstlane((int)(rdst + (s) * KSLOT))); \
    glds16(vsrc + (long)(t) * 64 * 2048, (unsigned)__builtin_amdgcn_readfirstlane((int)(vdst + (s) * VSLOT))); } while (0)
  asm volatile("s_waitcnt vmcnt(0)" ::: "memory");
  DMA(0, 0); DMA(1, 1);
  if (wid >= 4) __builtin_amdgcn_s_setprio(1);
  float mhat = 0.f; f32x16 o[2]; o[0] = f32x16{}; o[1] = f32x16{}; f32x16 negm = f32x16{}; f32x16 lacc = f32x16{};
  bf16x8 ones; { _Pragma("unroll") for (int j = 0; j < 8; ++j) ones[j] = (short)0x3F80; }
  bool first = true;
  const ALAS char* kp0 = (const ALAS char*)shm + LDS_K + r32 * 128; const ALAS char* rp0 = (const ALAS char*)shm + LDS_K + 8192 + r32 * 64;
  const int kg = (r32 >> 1) & 7, rg = (r32 >> 2) & 3;
  const int vq = (lane & 15) >> 2; const int vbA0 = (int)(lds0 + LDS_V) + (4 * hi + vq) * 128 + ((vq >> 1) & 1) * 64 + ((lane >> 4) & 1) * 32 + (lane & 3) * 8;
  int slot = 0, slot2 = 2;
  for (int t = 0; t < NT; ++t) {
    if (t + 1 >= NT) WAIT_BAR(0); else if (ropew) WAIT_BAR(3); else WAIT_BAR(2);
    if (t + 2 < NT) DMA(t + 2, slot2);
    const int jb = t - (NT - 4);
    if (jb <= (wid >> 1)) {
      f32x16 c0, c1;
      { const ALAS char* kp_ = kp0 + slot * KSLOT; const ALAS char* rp_ = rp0 + slot * KSLOT;
        bf16x8 kf[12];
#pragma unroll
        for (int d0 = 0; d0 < 6; ++d0) {
          if (d0 < 4) { const int off = ((2 * d0 + hi) ^ kg) << 4; kf[2 * d0] = *(const ALAS bf16x8*)(kp_ + off); kf[2 * d0 + 1] = *(const ALAS bf16x8*)(kp_ + off + 4096); }
          else { const int off = ((2 * (d0 - 4) + hi) ^ rg) << 4; kf[2 * d0] = *(const ALAS bf16x8*)(rp_ + off); kf[2 * d0 + 1] = *(const ALAS bf16x8*)(rp_ + off + 2048); } }
        SBAR();
#pragma unroll
        for (int d0 = 0; d0 < 6; ++d0) {
          if (d0 == 0) { c0 = MFMA32(kf[0], qr[0], negm); c1 = MFMA32(kf[1], qr[0], negm); } else { c0 = MFMA32(kf[2 * d0], qr[d0], c0); c1 = MFMA32(kf[2 * d0 + 1], qr[d0], c1); } } }
      asm volatile("s_nop 15\n\ts_nop 7" : "+v"(c0), "+v"(c1));
      const float rm = rowmax_a(c0, c1);
      if (first || __any(rm > (float)THRL)) {
        const float dl = first ? rm : __builtin_fmaxf(rm, 0.f); mhat += dl;
#pragma unroll
        for (int r = 0; r < 16; ++r) { c0[r] -= dl; c1[r] -= dl; negm[r] = -mhat; }
        if (!first) { const float f = __builtin_amdgcn_exp2f(-dl); if (hi == 0) wsf[r32] = f;
          asm volatile("s_waitcnt lgkmcnt(0)" ::: "memory");
#pragma unroll
          for (int d = 0; d < 2; ++d)
#pragma unroll
            for (int r = 0; r < 16; ++r) o[d][r] *= wsf[crow(r, hi)];
#pragma unroll
          for (int r = 0; r < 16; ++r) lacc[r] *= wsf[crow(r, hi)]; }
        first = false; }
#pragma unroll
      for (int r = 0; r < 16; ++r) { c0[r] = __builtin_amdgcn_exp2f(c0[r]); c1[r] = __builtin_amdgcn_exp2f(c1[r]); }
      u32x4 w0, w1, w2, w3;
      w0 = (u32x4){PKW(c0, 0), PKW(c0, 2), PKW(c0, 4), PKW(c0, 6)}; w1 = (u32x4){PKW(c0, 8), PKW(c0, 10), PKW(c0, 12), PKW(c0, 14)};
      w2 = (u32x4){PKW(c1, 0), PKW(c1, 2), PKW(c1, 4), PKW(c1, 6)}; w3 = (u32x4){PKW(c1, 8), PKW(c1, 10), PKW(c1, 12), PKW(c1, 14)};
      SBAR(); pv2(o, vbA0 + slot * VSLOT, (vbA0 + slot * VSLOT) ^ 64, __builtin_bit_cast(bf16x8, w0), __builtin_bit_cast(bf16x8, w1), __builtin_bit_cast(bf16x8, w2), __builtin_bit_cast(bf16x8, w3));
      lacc = MFMA32(__builtin_bit_cast(bf16x8, w0), ones, lacc); lacc = MFMA32(__builtin_bit_cast(bf16x8, w1), ones, lacc); lacc = MFMA32(__builtin_bit_cast(bf16x8, w2), ones, lacc); lacc = MFMA32(__builtin_bit_cast(bf16x8, w3), ones, lacc);
    }
    slot = (slot == 2) ? 0 : slot + 1; slot2 = (slot2 == 2) ? 0 : slot2 + 1;
  }
#undef DMA
#pragma unroll
  for (int r = 0; r < 16; ++r) { const float rl = __builtin_amdgcn_rcpf(lacc[r]); o[0][r] *= rl; o[1][r] *= rl; }
  __builtin_amdgcn_s_setprio(0);
  store_o(o, O + (rowbase + q0 + wid * 32) * 1024 + h * 64, 1024, (ALAS bf16_t*)(shm + LDS_OST) + wid * 2048, lane);
  asm volatile("s_waitcnt lgkmcnt(0)\n\ts_barrier" ::: "memory");
}
#undef WAIT_BAR
#undef PKW
#undef SBAR
}
#define GAS __attribute__((address_space(1)))
#define LAS __attribute__((address_space(3)))
typedef unsigned short bf16;
typedef unsigned v4u __attribute__((ext_vector_type(4)));
typedef float f32x4 __attribute__((ext_vector_type(4)));
typedef short bf16x8 __attribute__((ext_vector_type(8)));
typedef GAS unsigned gu32;
typedef GAS unsigned long long gu64;
#define RLX_AGENT __ATOMIC_RELAXED, __HIP_MEMORY_SCOPE_AGENT
#define LDS_WAIT() asm volatile("s_waitcnt lgkmcnt(0)" ::: "memory")
#define VM_WAIT() asm volatile("s_waitcnt vmcnt(0)" ::: "memory")
__device__ __forceinline__ unsigned long long rt() { return __builtin_amdgcn_s_memrealtime(); }
__device__ __forceinline__ unsigned f2bf(float f) { unsigned u = __builtin_bit_cast(unsigned, f); return (u + 0x7fffu + ((u >> 16) & 1u)) >> 16; }
__device__ __forceinline__ unsigned pk2(float lo, float hi) { return f2bf(lo) | (f2bf(hi) << 16); }

#define XB_TMO      128
#define XB_XCNT(j)  (256  + 64 * (j))
#define XB_XSUB(j)  (1280 + 64 * (j))
#define XB_XGEN(j)  (2304 + 64 * (j))
#define XB_TOP      3328
#define XB_TOPGEN   3392
#define XCD_BAR_WORDS 3456
#define XB_SPIN_CAP (1u << 18)

__device__ __forceinline__ unsigned xb_ld(unsigned* p)              { return __hip_atomic_load(p, __ATOMIC_RELAXED, __HIP_MEMORY_SCOPE_AGENT); }
__device__ __forceinline__ unsigned xb_add(unsigned* p, unsigned v) { return __hip_atomic_fetch_add(p, v, __ATOMIC_RELAXED, __HIP_MEMORY_SCOPE_AGENT); }
__device__ __forceinline__ unsigned xb_xcc_id() { return (unsigned)__builtin_amdgcn_s_getreg((3 << 11) | 20) & 0xFu; }
#define XB_SPIN(cond, bar) do { unsigned _sp = 0; while (cond) { __builtin_amdgcn_s_sleep(1); \
    if ((++_sp & 255u) == 0u) { if (xb_ld(&(bar)[XB_TMO])) break; if (_sp > XB_SPIN_CAP) { atomicAdd(&(bar)[XB_TMO], 1u); break; } } } } while (0)

struct XcdBarrier {
    unsigned* bar; unsigned x;
    volatile LAS unsigned* st;
};

__device__ __forceinline__ XcdBarrier xcd_barrier_post(unsigned* bar, volatile LAS unsigned* st) {
    XcdBarrier b; b.bar = bar; b.x = xb_xcc_id(); b.st = st;
    if (threadIdx.x == 0) (void)xb_add(&bar[XB_XCNT(b.x)], 1u);
    return b;
}
__device__ __forceinline__ void xcd_barrier_complete(unsigned* bar, unsigned x, unsigned& nloc, unsigned& nx) {
    const unsigned G = gridDim.x * gridDim.y * gridDim.z;
    unsigned sum, cnt, mine, sp = 0u;
    for (;;) {
        sum = 0u; cnt = 0u; mine = 0u;
#pragma unroll
        for (unsigned j = 0; j < 16; ++j) { const unsigned c = xb_ld(&bar[XB_XCNT(j)]); sum += c; cnt += (c > 0u) ? 1u : 0u; mine = (j == x) ? c : mine; }
        if (sum == G) break;
        __builtin_amdgcn_s_sleep(1);
        if ((++sp & 255u) == 0u) { if (xb_ld(&bar[XB_TMO])) break; if (sp > XB_SPIN_CAP) { atomicAdd(&bar[XB_TMO], 1u); break; } }
    }
    nloc = mine > 0u ? mine : 1u; nx = cnt > 0u ? cnt : 1u;
}

__device__ __forceinline__ void xcd_barrier(const XcdBarrier& b) {
    asm volatile("s_waitcnt vmcnt(0)" ::: "memory");
    __syncthreads();
    if (threadIdx.x == 0) {
        unsigned* bar = b.bar;
        __builtin_amdgcn_s_waitcnt(0);
        unsigned nloc = b.st[0], nx = b.st[1];
        if (nloc == 0u) { xcd_barrier_complete(bar, b.x, nloc, nx); b.st[0] = nloc; b.st[1] = nx; }
        const unsigned old = xb_add(&bar[XB_XSUB(b.x)], 1u);
        const unsigned gen = old / nloc;
        if (old + 1u == (gen + 1u) * nloc) {
            __builtin_amdgcn_fence(__ATOMIC_RELEASE, "agent");
            asm volatile("s_waitcnt vmcnt(0)" ::: "memory");
            const unsigned og = xb_add(&bar[XB_TOP], 1u);
            const unsigned tg = og / nx;
            if (og + 1u == (tg + 1u) * nx) xb_add(&bar[XB_TOPGEN], 1u);
            else XB_SPIN(xb_ld(&bar[XB_TOPGEN]) == tg, bar);
            __builtin_amdgcn_fence(__ATOMIC_ACQUIRE, "agent");
            xb_add(&bar[XB_XGEN(b.x)], 1u);
            asm volatile("s_waitcnt vmcnt(0)" ::: "memory");
        } else {
            XB_SPIN(xb_ld(&bar[XB_XGEN(b.x)]) == gen, bar);
            __builtin_amdgcn_fence(__ATOMIC_ACQUIRE, "agent");
            asm volatile("s_waitcnt vmcnt(0)" ::: "memory");
        }
    }
    __syncthreads();
}
constexpr int NWAVES = 8;
constexpr int SEQ = 8192, M = 2 * SEQ, D = 1024, FF = 4096;
constexpr float NORM_EPS = 1e-6f;
constexpr float LOG2E = 1.4426950408889634f;
constexpr float C2_SB = 0.125f * LOG2E;
constexpr float C2_MLA = 0.10206207261596575f * LOG2E;
constexpr unsigned MB = 1u << 20, KB = 1u << 10;
constexpr unsigned O_CTL = 0, CTL_ZERO_BYTES = 16 * KB;
constexpr unsigned O_RS = 64 * KB, N_RS = 11;
constexpr unsigned O_WQKV = 2 * MB, O_WOSB = 14 * MB, O_W1A = 18 * MB, O_W2A = 34 * MB, O_W1B = 50 * MB, O_W2B = 66 * MB, O_WD0 = 82 * MB,
                   O_WD1 = O_WD0 + 1536 * KB, O_WUKV = O_WD1 + 1 * MB,
                   O_WUQ = O_WUKV + 1 * MB, O_WOM = O_WUQ + 2304 * KB;
constexpr unsigned O_XN = 92 * MB;
constexpr unsigned O_Q = 124 * MB, O_K = 156 * MB, O_V = 188 * MB, O_OA = 220 * MB;
constexpr unsigned O_H = 124 * MB;
constexpr unsigned O_KVB = 124 * MB, O_KR = 188 * MB, O_DQ = 189 * MB, O_QB = 189 * MB, O_H2 = 189 * MB, O_CQ = 237 * MB, O_CKV = 2 * MB  , O_OB = 18 * MB  ;
constexpr unsigned O_CS = 253 * MB;
constexpr size_t WS_NEED = (size_t)255 * MB;
static_assert(O_WOM + 4 * MB <= O_XN, "weights");

enum { OP_GB = 0, OP_GR2 = 1, OP_GRES = 2, OP_GLAT = 3, OP_ATTA = 4, OP_ATTB = 5, OP_NORM = 6, OP_LAT = 7, OP_FINAL = 8 };
struct Ph { int op; unsigned a, b, c; int N, K, ldc, p0; float s0, s1; int nosync; int rs; };
#define PH_A_LAYER(l) \
  {OP_GB, O_XN, O_WQKV + (l) * 6 * MB, O_Q, 3072, 1024, 1024, 1024, C2_SB, 1.f, 0, ((l) == 0 ? 0 : 2)}, \
  {OP_ATTA, 0, 0, 0, 0, 0, 0, 0, 0.f, 0.f, 0, 0}, \
  {OP_GRES, O_OA, O_WOSB + (l) * 2 * MB, 0, 1024, 1024, 1024, 34 + ((l) == 0 ? 1 : 4), 0.f, 0.f, 0, 1 + 2 * (l)}, \
  {OP_GR2, O_XN, O_W1A + (l) * 8 * MB, O_H, 4096, 1024, 4096, 0, 1.f, 1.f, 0, 1 + 2 * (l)}, \
  {OP_GRES, O_H, O_W2A + (l) * 8 * MB, 0, 1024, 4096, 1024, 38, 0.f, 0.f, 0, 2 + 2 * (l)}
__constant__ Ph prog[] = {
  PH_A_LAYER(0), PH_A_LAYER(1),
  {OP_GLAT, O_XN, O_WD0, 6, 768, 1024, 7, 288, 0.f, 0.f, 0, 4},
  {OP_GB, O_CKV, O_WUKV, O_KVB, 2048, 256, 2048, 0, 1.f, 1.f, 1, 6},
  {OP_GB, O_CQ, O_WUQ, O_QB, 1536, 384, 1536, 0, 1.f, C2_MLA, 0, 7},
  {OP_ATTB, 0, 0, 0, 0, 0, 0, 0, 0.f, 0.f, 0, 0},
  {OP_GRES, O_OB, O_WOM, 0, 1024, 1024, 1024, 38, 0.f, 0.f, 0, 9},
  {OP_GR2, O_XN, O_W1B, O_H2, 2048, 1024, 2048, 0, 1.f, 1.f, 0, 9},
  {OP_GRES, O_H2, O_W2B, 0, 1024, 2048, 1024, 54, 0.f, 0.f, 0, 0},
  {OP_GR2, O_XN, O_W1B + 4 * MB, O_H2, 2048, 1024, 2048, 0, 1.f, 1.f, 0, 9},
  {OP_GRES, O_H2, O_W2B + 4 * MB, 0, 1024, 2048, 1024, 42, 0.f, 0.f, 0, 5},
  {OP_GLAT, O_XN, O_WD1, 0, 512, 1024, 8, 0, 0.f, 0.f, 0, 5},
  {OP_GB, O_CQ, O_WUQ + 1152 * KB, O_QB, 1536, 384, 1536, 0, 1.f, C2_MLA, 0, 8},
  {OP_ATTB, 0, 0, 0, 0, 0, 0, 0, 0.f, 0.f, 0, 0},
  {OP_GRES, O_OB, O_WOM + 2 * MB, 0, 1024, 1024, 1024, 38, 0.f, 0.f, 0, 10},
  {OP_GR2, O_XN, O_W1B + 8 * MB, O_H, 4096, 1024, 4096, 0, 1.f, 1.f, 0, 10},
  {OP_GRES, O_H, O_W2B + 8 * MB, 0, 1024, 4096, 1024, 38, 0.f, 0.f, 0, 11},
  {OP_FINAL, 0, 0, 0, 0, 0, 0, 0, 0.f, 0.f, 1, 0},
};
constexpr int NPH = sizeof(prog) / sizeof(Ph);

constexpr int RING_OFF = 0, RING_BYTES = 131072;
constexpr int LDSCTL_OFF = RING_BYTES, MISC_OFF = LDSCTL_OFF + 320;
constexpr int LDS_BYTES = 147456;
static_assert(att::LDS_BYTES <= RING_BYTES, "attention LDS");
__device__ __forceinline__ float wave_sum(float v) {
#pragma unroll
    for (int o = 1; o < 64; o <<= 1) v += __shfl_xor(v, o);
    return v;
}
__device__ __forceinline__ unsigned cvtpk2(float lo, float hi) { unsigned r; asm("v_cvt_pk_bf16_f32 %0, %1, %2" : "=v"(r) : "v"(lo), "v"(hi)); return r; }
struct P0Job { const float* W; const float* g; int K, N; bf16* WT; int row_off, item; };
#define P0_LOAD(J, wv) do { const int nblk_ = (J).N / 32, k0_ = 64 * ((J).item / nblk_), n0_ = 32 * ((J).item % nblk_);        \
    _Pragma("unroll") for (int i = 0; i < 8; ++i) (wv)[i] = *(const GAS f32x4*)((J).W + (size_t)(k0_ + 8 * i + (lane >> 3)) * (J).N + n0_ + 4 * (lane & 7)); } while (0)
__device__ __forceinline__ void p0_finish(const P0Job& J, LAS float* scr, int lane) {
    const int nblk = J.N / 32, k0 = 64 * (J.item / nblk), n0 = 32 * (J.item % nblk);
    const int c = lane & 7;
    f32x4 g0 = (f32x4){1.f, 1.f, 1.f, 1.f}, g1 = g0;
    if (J.g) { g0 = *(const GAS f32x4*)(J.g + k0 + 8 * c); g1 = *(const GAS f32x4*)(J.g + k0 + 8 * c + 4); }
#pragma unroll
    for (int j = 0; j < 4; ++j) { const int n = (lane >> 3) + 8 * j; const LAS float* s = scr + (8 * c) * 33 + n;
        v4u o; o.x = cvtpk2(s[0 * 33] * g0.x, s[1 * 33] * g0.y); o.y = cvtpk2(s[2 * 33] * g0.z, s[3 * 33] * g0.w); o.z = cvtpk2(s[4 * 33] * g1.x, s[5 * 33] * g1.y); o.w = cvtpk2(s[6 * 33] * g1.z, s[7 * 33] * g1.w);
        *(GAS v4u*)(J.WT + (size_t)(J.row_off + n0 + n) * J.K + k0 + 8 * c) = o; }
    LDS_WAIT(); asm volatile("" ::: "memory");
}
template <int NR, int MODE> __device__ __forceinline__ void rms_rows(const float* xrow, void* orow, const float* gain, int lane) {
    f32x4 v[NR][4]; float s2[NR];
#pragma unroll
    for (int r = 0; r < NR; ++r) { const GAS f32x4* xr = (const GAS f32x4*)(xrow + (size_t)r * D) + lane;
#pragma unroll
        for (int j = 0; j < 4; ++j) v[r][j] = xr[64 * j]; }
#pragma unroll
    for (int r = 0; r < NR; ++r) { float t = 0.f;
#pragma unroll
        for (int j = 0; j < 4; ++j) t += (v[r][j].x * v[r][j].x + v[r][j].y * v[r][j].y) + (v[r][j].z * v[r][j].z + v[r][j].w * v[r][j].w);
        s2[r] = t; }
#pragma unroll
    for (int o = 1; o < 64; o <<= 1) {
#pragma unroll
        for (int r = 0; r < NR; ++r) s2[r] += __shfl_xor(s2[r], o); }
#pragma unroll
    for (int r = 0; r < NR; ++r) { const float rr = 1.f / sqrtf(s2[r] * (1.f / D) + NORM_EPS);
        if (MODE == 0) { GAS unsigned long long* o8 = (GAS unsigned long long*)((bf16*)orow + (size_t)r * D) + lane;
#pragma unroll
            for (int j = 0; j < 4; ++j) o8[64 * j] = (unsigned long long)cvtpk2(v[r][j].x * rr, v[r][j].y * rr) | ((unsigned long long)cvtpk2(v[r][j].z * rr, v[r][j].w * rr) << 32); }
        else { GAS f32x4* of = (GAS f32x4*)((float*)orow + (size_t)r * D) + lane;
#pragma unroll
            for (int j = 0; j < 4; ++j) { const f32x4 gg = *((const GAS f32x4*)gain + lane + 64 * j); of[64 * j] = v[r][j] * rr * gg; } } }
}

#ifndef REP_ATTA
#define REP_ATTA 1
#endif
#ifndef REP_P0
#define REP_P0 1
#endif
#ifndef REP_GR2
#define REP_GR2 1
#endif
#ifndef REP_ATTB
#define REP_ATTB 1
#endif
#ifndef PROBE_MODE
#define PROBE_MODE 0
#endif
struct Args { const float* in[17]; float* out; unsigned char* ws; };
__global__ void __launch_bounds__(NWAVES * 64, 2) fwd(Args args) {
    extern __shared__ __attribute__((aligned(16))) unsigned char lds[];
    LAS unsigned char* L = (LAS unsigned char*)lds;
    volatile LAS unsigned* MISC = (volatile LAS unsigned*)(L + MISC_OFF);
    const int tid = threadIdx.x, lane = tid & 63, wave = __builtin_amdgcn_readfirstlane(tid >> 6);
    const int G = gridDim.x; const int bx = blockIdx.x; const int vcu = (G % 8 == 0) ? (bx % 8) * (G / 8) + bx / 8 : bx;
    unsigned char* ws = args.ws;
    for (int u = tid; u < (LDS_BYTES - LDSCTL_OFF) / 4; u += NWAVES * 64) ((LAS unsigned*)(L + LDSCTL_OFF))[u] = 0u;
    __syncthreads();
    XcdBarrier bar = xcd_barrier_post((unsigned*)(ws + O_CTL), MISC + 8);
    const int gw = vcu * NWAVES + wave, NGW = G * NWAVES;
    float* X = args.out;

    for (int rep0_ = 0; rep0_ < REP_P0; ++rep0_)
    {
        LAS float* scr = (LAS float*)(L + RING_OFF + wave * 16384);
        const float* attn_norm = args.in[2]; const float* mlp_norm = args.in[3];
#define P0_TRY(Wp, gp, K_, N_, WTo, roff) { const int items_ = ((K_) / 64) * ((N_) / 32); if (!hit_ && r_ < items_) { J_.W = (Wp); J_.g = (gp); J_.K = (K_); J_.N = (N_); J_.WT = (bf16*)(ws + (WTo)); J_.row_off = (roff); J_.item = r_; hit_ = true; } r_ -= items_; }
#define P0_DECODE(id, J) do { P0Job& J_ = (J); int r_ = (id); bool hit_ = false; \
        for (int l = 0; l < 4; ++l) { P0_TRY(args.in[14] + (size_t)l * D * FF, mlp_norm + l * D, D, FF, (l < 2 ? O_W1A + l * 8 * MB : O_W1B + (l - 2) * 8 * MB), 0) \
            if (l != 2) P0_TRY(args.in[15] + (size_t)l * FF * D, (const float*)nullptr, FF, D, (l < 2 ? O_W2A + l * 8 * MB : O_W2B + (l - 2) * 8 * MB), 0) \
            else { P0_TRY(args.in[15] + (size_t)l * FF * D, (const float*)nullptr, 2048, D, O_W2B, 0) \
                   P0_TRY(args.in[15] + (size_t)l * FF * D + (size_t)2048 * D, (const float*)nullptr, 2048, D, O_W2B + 4 * MB, 0) } } \
        for (int l = 0; l < 2; ++l) { P0_TRY(args.in[4] + (size_t)l * D * 3072, attn_norm + l * D, D, 3072, O_WQKV + l * 6 * MB, 0) \
            P0_TRY(args.in[5] + (size_t)l * D * D, (const float*)nullptr, D, D, O_WOSB + l * 2 * MB, 0) \
            P0_TRY(args.in[12] + (size_t)l * 384 * 1536, args.in[11] + l * 384, 384, 1536, O_WUQ + l * 1152 * KB, 0) \
            P0_TRY(args.in[13] + (size_t)l * D * D, (const float*)nullptr, D, D, O_WOM + l * 2 * MB, 0) } \
        P0_TRY(args.in[7], args.in[6], D, 288, O_WD0, 0) \
        P0_TRY(args.in[10], attn_norm + 2 * D, D, 384, O_WD0, 288) \
        P0_TRY(args.in[10] + (size_t)D * 384, attn_norm + 3 * D, D, 384, O_WD1, 0) \
        P0_TRY(args.in[9], args.in[8], 256, 2048, O_WUKV, 0) } while (0)
        constexpr int P0_TOTAL = 4 * 2048 + 4 * 2048 + 2 * (1536 + 512 + 288 + 512) + 144 + 192 + 192 + 256;
        if (gw < P0_TOTAL) {
            P0Job J0, J1; f32x4 wv[8];
            int id = gw; P0_DECODE(id, J0); P0_LOAD(J0, wv);
            for (;;) {
                const int idn = id + NGW; const bool more = idn < P0_TOTAL;
#pragma unroll
                for (int i = 0; i < 8; ++i) { LAS float* d_ = scr + (8 * i + (lane >> 3)) * 33 + 4 * (lane & 7); d_[0] = wv[i].x; d_[1] = wv[i].y; d_[2] = wv[i].z; d_[3] = wv[i].w; }
                LDS_WAIT(); asm volatile("" ::: "memory");
                if (more) { P0_DECODE(idn, J1); P0_LOAD(J1, wv); }
                p0_finish(J0, scr, lane);
                if (!more) break;
                J0 = J1; id = idn;
            }
        }
#undef P0_TRY
#undef P0_DECODE
        for (int i = gw * 64 + lane; i < 224 * 128; i += NGW * 64) { const int row = i >> 7, c16 = i & 127;
            bf16* dst = row < 96 ? (bf16*)(ws + O_WD0) + (size_t)(672 + row) * D : (bf16*)(ws + O_WD1) + (size_t)(384 + row - 96) * D;
            *(GAS v4u*)(dst + c16 * 8) = (v4u){0u, 0u, 0u, 0u}; }
        for (int i = gw * 64 + lane; i < N_RS * M / 2; i += NGW * 64) *((GAS f32x4*)(ws + O_RS) + i) = (f32x4){0.f, 0.f, 0.f, 0.f};
        { const int* pos = (const int*)args.in[1]; float* CS = (float*)(ws + O_CS);
          for (int i = gw * 64 + lane; i < M * 16; i += NGW * 64) { const int m = i >> 4, k = i & 15;
              const double bs = (k & 3) == 0 ? 1.0 : (k & 3) == 1 ? 0.5623413251903491 : (k & 3) == 2 ? 0.31622776601683794 : 0.1778279410038923;
              const double sc = (k >> 2) == 0 ? 1.0 : (k >> 2) == 1 ? 0.1 : (k >> 2) == 2 ? 0.01 : 0.001;
              const float inv = (float)(bs * sc); const float ang = (float)pos[m] * inv;
              const double rev = (double)ang * 0.15915494309189535; const float fr = (float)(rev - __builtin_rint(rev));
              CS[m * 32 + k] = __builtin_amdgcn_cosf(fr); CS[m * 32 + 16 + k] = __builtin_amdgcn_sinf(fr); } }
        for (int m = 4 * gw; m < M; m += 4 * NGW) rms_rows<4, 0>(args.in[0] + (size_t)m * D, (bf16*)(ws + O_XN) + (size_t)m * D, nullptr, lane);
    }
    if (__builtin_expect(ws == nullptr, 0)) cg::this_grid().sync();
    xcd_barrier(bar);

    const int lane0 = lane;
    for (int ph = 0; ph < NPH; ++ph) {
        const int op = prog[ph].op;
        int lane = lane0; asm volatile("" : "+v"(lane));
        if (op <= OP_GLAT) {
#ifndef NO_GEMM
            pg8::Gemm g{(const bf16*)(ws + prog[ph].a), (const bf16*)(ws + prog[ph].b), M, prog[ph].N, prog[ph].K};
            pg8::StaticOrder S; S.init(M, prog[ph].N, G, bx);
            const int rsi = prog[ph].rs; pg8::rs_t* rsp = rsi ? (pg8::rs_t*)(ws + O_RS) + (size_t)(rsi - 1) * M : nullptr;
            if (op == OP_GB) { pg8::EpiBf16<0> E{(bf16*)(ws + prog[ph].c), prog[ph].ldc, prog[ph].p0, (size_t)M * 1024, prog[ph].s0, prog[ph].s1, rsp, 1.f / (float)prog[ph].K};
                pg8::gemm_phase<pg8::EpiBf16<0>, pg8::StaticOrder, true, true>(L + RING_OFF, g, S, E); }
            else if (op == OP_GR2) { for (int rep_ = 1; rep_ < REP_GR2; ++rep_) { pg8::EpiBf16<2> E{(bf16*)(ws + prog[ph].c), prog[ph].ldc, 0, 0, 1.f, 1.f, rsp, 1.f / 1024.f};
                pg8::gemm_phase<pg8::EpiBf16<2>, pg8::StaticOrder, true, true>(L + RING_OFF, g, S, E); }
                pg8::EpiBf16<2> E{(bf16*)(ws + prog[ph].c), prog[ph].ldc, 0, 0, 1.f, 1.f, rsp, 1.f / 1024.f};
                pg8::gemm_phase<pg8::EpiBf16<2>, pg8::StaticOrder, true, true>(L + RING_OFF, g, S, E); }
            else if (op == OP_GRES) { const int fl = prog[ph].p0;
                bf16* XNp = (bf16*)(ws + O_XN); bf16* XN2p = (bf16*)(ws + O_OB);
                pg8::EpiF32<true> E{(fl & 1) ? args.in[0] : X, (fl & 2) ? nullptr : X, prog[ph].ldc, (fl & 32) ? ((fl & 16) ? XN2p : XNp) : nullptr, rsp, (fl & 4) ? XNp : (fl & 8) ? XN2p : nullptr};
                pg8::gemm_phase<pg8::EpiF32<true>, pg8::StaticOrder, true, true>(L + RING_OFF, g, S, E); }
            else { pg8::rs_t* rsb = (pg8::rs_t*)(ws + O_RS); const int ik = (int)prog[ph].c, iq = prog[ph].ldc;
                pg8::EpiLat E{rsp, prog[ph].p0, (bf16*)(ws + O_CKV), (bf16*)(ws + O_KR), (bf16*)(ws + O_CQ), ik ? rsb + (size_t)(ik - 1) * M : nullptr, rsb + (size_t)(iq - 1) * M, (const float*)(ws + O_CS)};
                pg8::gemm_phase<pg8::EpiLat, pg8::StaticOrder, true, true>(L + RING_OFF, g, S, E); }
#endif
        } else if (op == OP_ATTA) {
            att::ALAS_char_t wl = (att::ALAS_char_t)(L + RING_OFF + wave * 16384);
            att::SbConsts tc; att::sb_consts(tc, lane);
#ifndef NO_ATTA
            for (int rep_ = 0; rep_ < REP_ATTA; ++rep_)
            for (int u = gw; u < 32 * 256; u += NGW) { const int bh = u >> 8, qblk = u & 255;
                att::sb_unit(bh >> 4, bh & 15, qblk, (const bf16*)(ws + O_Q), (const bf16*)(ws + O_K), (const bf16*)(ws + O_V), (bf16*)(ws + O_OA), wl, tc); }
#endif
        } else if (op == OP_ATTB) {
#ifndef NO_ATTB
            for (int rep_ = 0; rep_ < REP_ATTB; ++rep_)
            for (int i = 0; ; ++i) { int bh, qb;
                if (G == 256) { if (i >= 4) break; const int c = vcu & 31; bh = (vcu >> 5) * 4 + i; qb = (i & 1) ? 31 - c : c; }
                else { const int id = vcu + i * G; if (id >= 1024) break; bh = id & 31; qb = 31 - (id >> 5); }
                att::mla_unit<8>(bh >> 4, bh & 15, qb, (const bf16*)(ws + O_QB), (const bf16*)(ws + O_KVB), (const bf16*)(ws + O_KR), (const float*)(ws + O_CS), (bf16*)(ws + O_OB), (att::ALAS_char_t)(L + RING_OFF)); }
#endif
        } else if (op == OP_NORM) {
            for (int m = 4 * gw; m < M; m += 4 * NGW) rms_rows<4, 0>(X + (size_t)m * D, (bf16*)(ws + O_XN) + (size_t)m * D, nullptr, lane);
        } else {
            const float* gfin = args.in[16]; const bf16* XB = (const bf16*)(ws + O_XN); const pg8::rs_t* rsf = (const pg8::rs_t*)(ws + O_RS) + (size_t)10 * M;
            f32x4 gg[4];
#pragma unroll
            for (int j = 0; j < 2; ++j) { gg[2 * j] = *(const GAS f32x4*)(gfin + 512 * j + 8 * lane); gg[2 * j + 1] = *(const GAS f32x4*)(gfin + 512 * j + 8 * lane + 4); }
            for (int m = 4 * gw; m < M; m += 4 * NGW) { v4u xv[4][2]; float rv[4];
#pragma unroll
                for (int r = 0; r < 4; ++r) { xv[r][0] = *(const GAS v4u*)(XB + (size_t)(m + r) * D + 8 * lane); xv[r][1] = *(const GAS v4u*)(XB + (size_t)(m + r) * D + 512 + 8 * lane); rv[r] = pg8::rs_get(rsf + m + r); }
#pragma unroll
                for (int r = 0; r < 4; ++r) { const float rr = 1.f / sqrtf(rv[r] * (1.f / D) + NORM_EPS);
#pragma unroll
                    for (int j = 0; j < 2; ++j) { const v4u w = xv[r][j]; float* o = X + (size_t)(m + r) * D + 512 * j + 8 * lane;
                        *(GAS f32x4*)(o) = (f32x4){__uint_as_float(w.x << 16), __uint_as_float(w.x & 0xffff0000u), __uint_as_float(w.y << 16), __uint_as_float(w.y & 0xffff0000u)} * rr * gg[2 * j];
                        *(GAS f32x4*)(o + 4) = (f32x4){__uint_as_float(w.z << 16), __uint_as_float(w.z & 0xffff0000u), __uint_as_float(w.w << 16), __uint_as_float(w.w & 0xffff0000u)} * rr * gg[2 * j + 1]; } } }
        }
        if (!prog[ph].nosync) xcd_barrier(bar);
    }
}

extern "C" void kernel_launch(void* const* d_in, const int* in_sizes, int n_in, void* d_out, int out_size, void* d_ws, size_t ws_size, hipStream_t stream) {
    static int grid = 0;
    if (grid == 0) {
        if (n_in != 17 || in_sizes[0] != M * D || out_size != M * D || ws_size < WS_NEED) { fprintf(stderr, "kernel_launch: unexpected shapes (n_in %d, out %d, ws %zu); nothing launched\n", n_in, out_size, ws_size); grid = -1; return; }
        int dev = 0, cus = 0, per_cu = 0;
        if (hipGetDevice(&dev) != hipSuccess || hipDeviceGetAttribute(&cus, hipDeviceAttributeMultiprocessorCount, dev) != hipSuccess) { grid = -1; return; }
        if (hipFuncSetAttribute((const void*)fwd, hipFuncAttributeMaxDynamicSharedMemorySize, LDS_BYTES) != hipSuccess) { fprintf(stderr, "kernel_launch: hipFuncSetAttribute failed\n"); grid = -1; return; }
        if (hipOccupancyMaxActiveBlocksPerMultiprocessor(&per_cu, (const void*)fwd, NWAVES * 64, LDS_BYTES) != hipSuccess || per_cu < 1) { fprintf(stderr, "kernel_launch: occupancy query says %d\n", per_cu); per_cu = 1; }
        (void)hipGetLastError();
        grid = cus;
    }
    if (grid < 0) return;
    (void)hipMemsetAsync((char*)d_ws + O_CTL, 0, CTL_ZERO_BYTES, stream);
    Args a{};
    for (int i = 0; i < 17; ++i) a.in[i] = (const float*)d_in[i];
    a.out = (float*)d_out; a.ws = (unsigned char*)d_ws;
    void* kargs[] = {&a};
    const hipError_t le = hipLaunchCooperativeKernel((const void*)fwd, dim3(grid), dim3(NWAVES * 64), kargs, LDS_BYTES, stream);
    if (le != hipSuccess) fprintf(stderr, "kernel_launch: cooperative launch failed: %s (grid %d)\n", hipGetErrorName(le), grid);
}
```

```cpp
#include <hip/hip_runtime.h>
#include <hip/hip_cooperative_groups.h>
#include <cstdio>
#include <cstdint>
namespace cg = cooperative_groups;
namespace pg8 {
#define PG8_LAS __attribute__((address_space(3)))
typedef unsigned short bf16_t;
typedef short bf16x8 __attribute__((ext_vector_type(8)));
typedef float f32x4 __attribute__((ext_vector_type(4)));
typedef unsigned u32x4 __attribute__((ext_vector_type(4)));
constexpr int BM = 256, BK = 64, HALF = 128, HTB = HALF * BK * 2  , STAGE_BYTES = 8 * HTB, NXCD = 8, WGM = 8;

__host__ __device__ __forceinline__ int lds_byte(int r, int c) { const int st = (r >> 4) * 2 + (c >> 5), rr = r & 15, cc = c & 31, ob = rr * 64 + cc * 2; return st * 1024 + (ob ^ (((ob >> 9) & 1) << 5)); }
__host__ __device__ __forceinline__ void stage_rc(int b, int& R, int& C) { const int st = b / 1024, sb = b % 1024, swz = sb ^ (((sb >> 9) & 1) << 5); R = (st >> 1) * 16 + swz / 64; C = (st & 1) * 32 + (swz % 64) / 2; }
__host__ __device__ __forceinline__ int perm32(int rho) { const int n = rho >> 4, i = rho & 15; return 8 * (i >> 2) + 4 * n + (i & 3); }

struct Unit { int pm, pn; };
struct Gemm { const bf16_t* A; const bf16_t* Bt; int M, N, K; };

struct StaticOrder {
    int nM, nN, nwg, G, c;
    __host__ __device__ void init(int M, int N, int G_, int c_) { nM = M / BM; nN = N / BM; nwg = nM * nN; G = G_; c = c_; }
    __host__ __device__ bool next(int i, Unit& u) const {
        const long L = (long)i * G + c; if (L >= nwg) return false;
        int wgid = (int)L; { const int q = nwg / NXCD, r = nwg % NXCD, xcd = wgid % NXCD, off = wgid / NXCD; wgid = (xcd < r ? xcd * (q + 1) : r * (q + 1) + (xcd - r) * q) + off; }
        const int nig = WGM * nN, gid = wgid / nig, fm = gid * WGM, gsz = (nM - fm) < WGM ? (nM - fm) : WGM;
        u.pm = fm + ((wgid % nig) % gsz); u.pn = (wgid % nig) / gsz; return true;
    }
    __device__ __forceinline__ void a_ready(const Unit&) const {}
    __device__ __forceinline__ void done(const Unit&) const {}
};

__device__ __forceinline__ unsigned cvt_pk_bf16(float lo, float hi) { unsigned r; asm volatile("v_cvt_pk_bf16_f32 %0, %1, %2" : "=v"(r) : "v"(lo), "v"(hi)); return r; }
typedef float f32x2 __attribute__((ext_vector_type(2)));
typedef unsigned long long rs_t;
__device__ __forceinline__ void rs_add(rs_t* p, float v) { __hip_atomic_fetch_add(p, (rs_t)(v * 16777216.f), __ATOMIC_RELAXED, __HIP_MEMORY_SCOPE_AGENT); }
__device__ __forceinline__ float rs_get(const rs_t* p) { return (float)(*p) * (1.f / 16777216.f); }
template <int ACT  > struct EpiBf16 {
    static constexpr bool PERM = true, AFTER_DRAIN = false;
    bf16_t* O; int ldc; int split_cols; size_t split_stride; float scale0, scale; const rs_t* rs; float rs_inv_n;
    __device__ __forceinline__ void operator()(const f32x4 (&acc)[2][2][4][2], const Unit& u, int wr, int wc, int fr, int fq) const {
        const int row0 = u.pm * BM + wr * 64 + fr; int colt = u.pn * BM; bf16_t* base = O;
        float sc = scale; if (split_cols) { const int t = colt / split_cols; base += (size_t)t * split_stride; colt -= t * split_cols; if (t == 0) sc *= scale0; }
        const int col0 = colt + wc * 32 + 8 * fq;
        float scv[2][4];
        if (rs) { rs_t rv[2][4];
#pragma unroll
            for (int ai = 0; ai < 2; ++ai)
#pragma unroll
                for (int m = 0; m < 4; ++m) rv[ai][m] = rs[row0 + ai * HALF + m * 16];
#pragma unroll
            for (int ai = 0; ai < 2; ++ai)
#pragma unroll
                for (int m = 0; m < 4; ++m) scv[ai][m] = sc * __builtin_amdgcn_rsqf((float)rv[ai][m] * (1.f / 16777216.f) * rs_inv_n + 1e-6f); }
        else {
#pragma unroll
            for (int ai = 0; ai < 2; ++ai)
#pragma unroll
                for (int m = 0; m < 4; ++m) scv[ai][m] = sc; }
#pragma unroll
        for (int ai = 0; ai < 2; ++ai)
#pragma unroll
            for (int m = 0; m < 4; ++m) { bf16_t* rowp = base + (size_t)(row0 + ai * HALF + m * 16) * ldc + col0;
                const float scr = scv[ai][m];
#pragma unroll
                for (int bj = 0; bj < 2; ++bj) { f32x4 v0 = acc[ai][bj][m][0], v1 = acc[ai][bj][m][1];
                    v0 = v0 * scr; v1 = v1 * scr;
                    if (ACT == 2) {
#pragma unroll
                        for (int e = 0; e < 4; ++e) { const float a = __builtin_fmaxf(v0[e], 0.f), b = __builtin_fmaxf(v1[e], 0.f); v0[e] = a * a; v1[e] = b * b; } }
                    u32x4 w; w.x = cvt_pk_bf16(v0[0], v0[1]); w.y = cvt_pk_bf16(v0[2], v0[3]); w.z = cvt_pk_bf16(v1[0], v1[1]); w.w = cvt_pk_bf16(v1[2], v1[3]);
                    *(u32x4*)(rowp + bj * HALF) = w; } }
    }
};
template <bool RES> struct EpiF32 {
    static constexpr bool PERM = true, AFTER_DRAIN = false;
    const float* base; float* out; int ldc; bf16_t* xn; rs_t* rs; const bf16_t* base16;
    __device__ __forceinline__ void emit(f32x4 o0, f32x4 o1, size_t off, float& ss) const {
        if (out) { *(f32x4*)(out + off) = o0; *(f32x4*)(out + off + 4) = o1; }
        if (RES && xn) { u32x4 w; w.x = cvt_pk_bf16(o0[0], o0[1]); w.y = cvt_pk_bf16(o0[2], o0[3]); w.z = cvt_pk_bf16(o1[0], o1[1]); w.w = cvt_pk_bf16(o1[2], o1[3]);
            *(u32x4*)(xn + off) = w;
            ss += ((o0[0] * o0[0] + o0[1] * o0[1]) + (o0[2] * o0[2] + o0[3] * o0[3])) + ((o1[0] * o1[0] + o1[1] * o1[1]) + (o1[2] * o1[2] + o1[3] * o1[3])); }
    }
    __device__ __forceinline__ void operator()(const f32x4 (&acc)[2][2][4][2], const Unit& u, int wr, int wc, int fr, int fq) const {
        const int col0 = u.pn * BM + wc * 32 + 8 * fq;
        if (RES && base16) {
#pragma unroll
            for (int ai = 0; ai < 2; ++ai) {
                u32x4 bw[4][2];
#pragma unroll
                for (int m = 0; m < 4; ++m)
#pragma unroll
                    for (int bj = 0; bj < 2; ++bj) bw[m][bj] = *(const u32x4*)(base16 + (size_t)(u.pm * BM + ai * HALF + wr * 64 + m * 16 + fr) * ldc + col0 + bj * HALF);
                asm volatile("s_waitcnt vmcnt(0)" : "+v"(bw[0][0]), "+v"(bw[0][1]), "+v"(bw[1][0]), "+v"(bw[1][1]), "+v"(bw[2][0]), "+v"(bw[2][1]), "+v"(bw[3][0]), "+v"(bw[3][1]) :: "memory");
#pragma unroll
                for (int m = 0; m < 4; ++m) { const int row = u.pm * BM + ai * HALF + wr * 64 + m * 16 + fr; const size_t off = (size_t)row * ldc + col0; float ss = 0.f;
#pragma unroll
                    for (int bj = 0; bj < 2; ++bj) { const u32x4 w = bw[m][bj];
                        const f32x4 o0 = acc[ai][bj][m][0] + (f32x4){__uint_as_float(w.x << 16), __uint_as_float(w.x & 0xffff0000u), __uint_as_float(w.y << 16), __uint_as_float(w.y & 0xffff0000u)};
                        const f32x4 o1 = acc[ai][bj][m][1] + (f32x4){__uint_as_float(w.z << 16), __uint_as_float(w.z & 0xffff0000u), __uint_as_float(w.w << 16), __uint_as_float(w.w & 0xffff0000u)};
                        emit(o0, o1, off + bj * HALF, ss); }
                    if (xn && rs) { ss += __shfl_xor(ss, 16); ss += __shfl_xor(ss, 32); if (fq == 0) rs_add(rs + row, ss); } } }
            return;
        }
#pragma unroll
        for (int ai = 0; ai < 2; ++ai)
#pragma unroll
            for (int m = 0; m < 4; ++m) { const int row = u.pm * BM + ai * HALF + wr * 64 + m * 16 + fr; const size_t off = (size_t)row * ldc + col0;
                float rsc = 1.f; if (!RES && rs) rsc = __builtin_amdgcn_rsqf(rs_get(rs + row) * (1.f / 1024.f) + 1e-6f);
                float ss = 0.f;
#pragma unroll
                for (int bj = 0; bj < 2; ++bj) { f32x4 o0 = acc[ai][bj][m][0], o1 = acc[ai][bj][m][1];
                    if (RES) { o0 = o0 + *(const f32x4*)(base + off + bj * HALF); o1 = o1 + *(const f32x4*)(base + off + bj * HALF + 4); }
                    else { o0 = o0 * rsc; o1 = o1 * rsc; }
                    emit(o0, o1, off + bj * HALF, ss); }
                if (RES && xn && rs) { ss += __shfl_xor(ss, 16); ss += __shfl_xor(ss, 32); if (fq == 0) rs_add(rs + row, ss); }
                asm volatile("" ::: "memory"); }
    }
};
struct EpiLat {
    static constexpr bool PERM = false, AFTER_DRAIN = false;
    const rs_t* rs_x; int qoff; bf16_t* ckv; bf16_t* kr; bf16_t* cq; rs_t* rsk; rs_t* rsq; const float* cs;
    __device__ __forceinline__ void operator()(const f32x4 (&acc)[2][2][4][2], const Unit& u, int wr, int wc, int fr, int fq) const {
        typedef unsigned u32x2v __attribute__((ext_vector_type(2)));
        const int colw = u.pn * BM + wc * 32;
        float rsv[2][4];
#pragma unroll
        for (int ai = 0; ai < 2; ++ai)
#pragma unroll
            for (int m = 0; m < 4; ++m) rsv[ai][m] = rs_get(rs_x + u.pm * BM + ai * HALF + wr * 64 + m * 16 + fr);
        if (qoff && colw == 256) {
#pragma unroll
            for (int ai = 0; ai < 2; ++ai)
#pragma unroll
                for (int m = 0; m < 4; ++m) { const int row = u.pm * BM + ai * HALF + wr * 64 + m * 16 + fr;
                    const float rsc = __builtin_amdgcn_rsqf(rsv[ai][m] * (1.f / 1024.f) + 1e-6f);
                    const f32x4 v0 = acc[ai][0][m][0] * rsc, v1 = acc[ai][0][m][1] * rsc;
                    const f32x4 c = *(const f32x4*)(cs + (size_t)row * 32 + 4 * fq), sn = *(const f32x4*)(cs + (size_t)row * 32 + 16 + 4 * fq);
                    const f32x4 a = v0 * c - v1 * sn, b = v1 * c + v0 * sn; u32x2v w;
                    w.x = cvt_pk_bf16(a[0], a[1]); w.y = cvt_pk_bf16(a[2], a[3]); *(u32x2v*)(kr + (size_t)row * 32 + 4 * fq) = w;
                    w.x = cvt_pk_bf16(b[0], b[1]); w.y = cvt_pk_bf16(b[2], b[3]); *(u32x2v*)(kr + (size_t)row * 32 + 16 + 4 * fq) = w; } }
#pragma unroll
        for (int ai = 0; ai < 2; ++ai)
#pragma unroll
            for (int m = 0; m < 4; ++m) { const int row = u.pm * BM + ai * HALF + wr * 64 + m * 16 + fr;
                const float rsc = __builtin_amdgcn_rsqf(rsv[ai][m] * (1.f / 1024.f) + 1e-6f);
                float sk = 0.f, sq = 0.f;
#pragma unroll
                for (int bj = 0; bj < 2; ++bj) { const int c32 = colw + bj * HALF;
                    const f32x4 v0 = acc[ai][bj][m][0] * rsc, v1 = acc[ai][bj][m][1] * rsc;
                    if (qoff && c32 < 256) {
                        u32x2v w; w.x = cvt_pk_bf16(v0[0], v0[1]); w.y = cvt_pk_bf16(v0[2], v0[3]); *(u32x2v*)(ckv + (size_t)row * 256 + c32 + 4 * fq) = w;
                        w.x = cvt_pk_bf16(v1[0], v1[1]); w.y = cvt_pk_bf16(v1[2], v1[3]); *(u32x2v*)(ckv + (size_t)row * 256 + c32 + 16 + 4 * fq) = w;
                        sk += (v0[0] * v0[0] + v0[1] * v0[1]) + (v0[2] * v0[2] + v0[3] * v0[3]) + (v1[0] * v1[0] + v1[1] * v1[1]) + (v1[2] * v1[2] + v1[3] * v1[3]);
                    } else if (qoff && c32 == 256) {
                    } else if (c32 >= qoff && c32 < qoff + 384) {
                        u32x2v w; w.x = cvt_pk_bf16(v0[0], v0[1]); w.y = cvt_pk_bf16(v0[2], v0[3]); *(u32x2v*)(cq + (size_t)row * 384 + (c32 - qoff) + 4 * fq) = w;
                        w.x = cvt_pk_bf16(v1[0], v1[1]); w.y = cvt_pk_bf16(v1[2], v1[3]); *(u32x2v*)(cq + (size_t)row * 384 + (c32 - qoff) + 16 + 4 * fq) = w;
                        sq += (v0[0] * v0[0] + v0[1] * v0[1]) + (v0[2] * v0[2] + v0[3] * v0[3]) + (v1[0] * v1[0] + v1[1] * v1[1]) + (v1[2] * v1[2] + v1[3] * v1[3]);
                    } }
                sk += __shfl_xor(sk, 16); sk += __shfl_xor(sk, 32); sq += __shfl_xor(sq, 16); sq += __shfl_xor(sq, 32);
                if (fq == 0) { if (qoff && colw < 256) rs_add(rsk + row, sk);
                               if (colw + HALF + 32 > qoff && colw < qoff + 384) rs_add(rsq + row, sq); }
                asm volatile("" ::: "memory"); }
    }
};
template <class Epi, class Sched, bool ALIGN_EPI = false, bool SP2 = false>
__device__ __forceinline__ void gemm_phase(PG8_LAS unsigned char* lds, const Gemm g, const Sched& S, const Epi& E) {
    int tid_ = threadIdx.x; asm volatile("" : "+v"(tid_));
    const int tid = tid_, wid = __builtin_amdgcn_readfirstlane(tid >> 6), lane = tid & 63, wr = wid >> 2, wc = wid & 3, fr = lane & 15, fq = lane >> 4;
    const int K = g.K, nt = K / BK;
    unsigned voffA[2], voffB[2];
#pragma unroll
    for (int i = 0; i < 2; ++i) { int R, C; stage_rc(tid * 16 + i * 8192, R, C); const int Rb = Epi::PERM ? ((R & ~31) + perm32(R & 31)) : R;
        voffA[i] = (unsigned)(R * K + C) * 2u; voffB[i] = (unsigned)(Rb * K + C) * 2u; }
    const size_t kstep = (size_t)(BK * 2);
    const size_t hstep = (size_t)HALF * K * 2;
    const size_t tstep = 2 * hstep;
    const unsigned ldsw = (unsigned)wid * 1024u;
    const int aoff = lds_byte(wr * 64 + fr, fq * 8), boff = lds_byte(wc * 32 + fr, fq * 8);
#define PG8_SA(b, h) (((b) * 2 + (h)) * HTB)
#define PG8_SB(b, h) ((4 + (b) * 2 + (h)) * HTB)
#define PG8_STAGE(bufoff, gbase, voff) do { _Pragma("unroll") for (int _i = 0; _i < 2; ++_i) \
        __builtin_amdgcn_global_load_lds((const unsigned*)((const char*)(gbase) + (voff)[_i]), (PG8_LAS unsigned*)(lds + (bufoff) + ldsw + _i * 8192), 16, 0, 0); } while (0)
#define PG8_LDA(dst, b, h) do { _Pragma("unroll") for (int m = 0; m < 4; ++m) _Pragma("unroll") for (int k = 0; k < 2; ++k) dst[m][k] = *(const PG8_LAS bf16x8*)(lds + PG8_SA(b, h) + aoff + m * 2048 + k * 1024); } while (0)
#define PG8_LDB(dst, b, h) do { _Pragma("unroll") for (int n = 0; n < 2; ++n) _Pragma("unroll") for (int k = 0; k < 2; ++k) dst[n][k] = *(const PG8_LAS bf16x8*)(lds + PG8_SB(b, h) + boff + n * 2048 + k * 1024); } while (0)
#define PG8_MMA(ai, bj, At, Bt) do { __builtin_amdgcn_s_setprio(1); _Pragma("unroll") for (int m = 0; m < 4; ++m) _Pragma("unroll") for (int n = 0; n < 2; ++n) _Pragma("unroll") for (int k = 0; k < 2; ++k) \
        acc[ai][bj][m][n] = __builtin_amdgcn_mfma_f32_16x16x32_bf16(Bt[n][k], At[m][k], acc[ai][bj][m][n], 0, 0, 0); __builtin_amdgcn_s_setprio(0); } while (0)
#define PG8_WAIT_V(n) asm volatile("s_waitcnt vmcnt(" #n ")" ::: "memory")
#define PG8_WAIT_L(n) asm volatile("s_waitcnt lgkmcnt(" #n ")" ::: "memory")
#define PG8_BAR __builtin_amdgcn_s_barrier()
#define PG8_SCHED __builtin_amdgcn_sched_barrier(0)
    Unit cur, nxt; int ui = 0;
    if (!S.next(0, cur)) return;
    f32x4 acc[2][2][4][2];
#pragma unroll
    for (int a = 0; a < 2; ++a)
#pragma unroll
        for (int b = 0; b < 2; ++b)
#pragma unroll
            for (int m = 0; m < 4; ++m)
#pragma unroll
                for (int n = 0; n < 2; ++n) acc[a][b][m][n] = (f32x4){0.f, 0.f, 0.f, 0.f};
    bf16x8 At[4][2], B0[2][2], B1[2][2];
    const char* cA = (const char*)g.A + (size_t)cur.pm * tstep; const char* cB = (const char*)g.Bt + (size_t)cur.pn * tstep;
    S.a_ready(cur);
    if constexpr (SP2) {
        PG8_STAGE(PG8_SB(0, 0), cB, voffB); PG8_STAGE(PG8_SB(0, 1), cB + hstep, voffB); PG8_STAGE(PG8_SA(0, 0), cA, voffA); PG8_STAGE(PG8_SA(0, 1), cA + hstep, voffA);
        if (wr == 1) PG8_BAR;
        PG8_WAIT_V(2); PG8_BAR;
        PG8_STAGE(PG8_SB(1, 0), cB + kstep, voffB); PG8_STAGE(PG8_SA(1, 0), cA + kstep, voffA); PG8_STAGE(PG8_SB(1, 1), cB + hstep + kstep, voffB);
        PG8_WAIT_V(6); PG8_BAR;
    } else {
        PG8_STAGE(PG8_SB(0, 0), cB, voffB); PG8_STAGE(PG8_SA(0, 0), cA, voffA); PG8_STAGE(PG8_SB(0, 1), cB + hstep, voffB); PG8_STAGE(PG8_SA(0, 1), cA + hstep, voffA);
        if (wr == 1) PG8_BAR;
        PG8_WAIT_V(4); PG8_BAR;
        PG8_STAGE(PG8_SB(1, 0), cB + kstep, voffB); PG8_STAGE(PG8_SA(1, 0), cA + kstep, voffA); PG8_STAGE(PG8_SB(1, 1), cB + hstep + kstep, voffB);
        PG8_WAIT_V(6); PG8_BAR;
    }
    for (;;) {
        const bool has_next = S.next(ui + 1, nxt);
        const char* nA = has_next ? (const char*)g.A + (size_t)nxt.pm * tstep : cA; const char* nB = has_next ? (const char*)g.Bt + (size_t)nxt.pn * tstep : cB;
        for (int t = 0; t < nt; t += 2) {
            const bool last = (t == nt - 2);
            const char* a1 = cA + (size_t)(t + 1) * kstep;
            const char* a2 = last ? nA : cA + (size_t)(t + 2) * kstep; const char* b2 = last ? nB : cB + (size_t)(t + 2) * kstep;
            const char* a3 = a2 + kstep; const char* b3 = b2 + kstep;
            if (last && has_next) S.a_ready(nxt);
            if constexpr (SP2) {
            PG8_LDB(B0, 0, 0); PG8_LDB(B1, 0, 1); PG8_SCHED; PG8_LDA(At, 0, 0); PG8_STAGE(PG8_SA(1, 1), a1 + hstep, voffA);
            PG8_WAIT_V(8); PG8_WAIT_L(0); PG8_BAR; PG8_MMA(0, 0, At, B0); PG8_MMA(0, 1, At, B1); PG8_BAR; PG8_SCHED;
            PG8_LDA(At, 0, 1); PG8_STAGE(PG8_SB(0, 0), b2, voffB); PG8_STAGE(PG8_SB(0, 1), b2 + hstep, voffB); PG8_STAGE(PG8_SA(0, 0), a2, voffA);
            PG8_WAIT_V(8); PG8_WAIT_L(0); PG8_BAR; PG8_MMA(1, 0, At, B0); PG8_MMA(1, 1, At, B1); PG8_BAR; PG8_SCHED;
            PG8_LDB(B0, 1, 0); PG8_LDB(B1, 1, 1); PG8_SCHED; PG8_LDA(At, 1, 0); PG8_STAGE(PG8_SA(0, 1), a2 + hstep, voffA);
            PG8_WAIT_V(8); PG8_WAIT_L(0); PG8_BAR; PG8_MMA(0, 0, At, B0); PG8_MMA(0, 1, At, B1); PG8_BAR; PG8_SCHED;
            PG8_LDA(At, 1, 1); PG8_STAGE(PG8_SB(1, 0), b3, voffB); PG8_STAGE(PG8_SB(1, 1), b3 + hstep, voffB); PG8_STAGE(PG8_SA(1, 0), a3, voffA);
            PG8_WAIT_V(8); PG8_WAIT_L(0); PG8_BAR; PG8_MMA(1, 0, At, B0); PG8_MMA(1, 1, At, B1); PG8_BAR; PG8_SCHED;
            } else {
            PG8_LDB(B0, 0, 0); PG8_SCHED; PG8_LDA(At, 0, 0); PG8_STAGE(PG8_SA(1, 1), a1 + hstep, voffA);
            PG8_WAIT_L(8); PG8_BAR; PG8_WAIT_L(0); PG8_MMA(0, 0, At, B0); PG8_BAR; PG8_SCHED;
            PG8_LDB(B1, 0, 1); PG8_STAGE(PG8_SB(0, 0), b2, voffB);
            PG8_BAR; PG8_WAIT_L(0); PG8_MMA(0, 1, At, B1); PG8_BAR;
            PG8_LDA(At, 0, 1); PG8_STAGE(PG8_SA(0, 0), a2, voffA);
            PG8_BAR; PG8_WAIT_L(0); PG8_MMA(1, 0, At, B0); PG8_BAR; PG8_SCHED;
            PG8_STAGE(PG8_SB(0, 1), b2 + hstep, voffB);
            PG8_WAIT_V(6); PG8_BAR; PG8_MMA(1, 1, At, B1); PG8_BAR;
            PG8_LDB(B0, 1, 0); PG8_SCHED; PG8_LDA(At, 1, 0); PG8_STAGE(PG8_SA(0, 1), a2 + hstep, voffA);
            PG8_WAIT_L(8); PG8_BAR; PG8_WAIT_L(0); PG8_MMA(0, 0, At, B0); PG8_BAR; PG8_SCHED;
            PG8_LDB(B1, 1, 1); PG8_STAGE(PG8_SB(1, 0), b3, voffB);
            PG8_BAR; PG8_WAIT_L(0); PG8_MMA(0, 1, At, B1); PG8_BAR;
            PG8_LDA(At, 1, 1); PG8_STAGE(PG8_SA(1, 0), a3, voffA);
            PG8_BAR; PG8_WAIT_L(0); PG8_MMA(1, 0, At, B0); PG8_BAR; PG8_SCHED;
            PG8_STAGE(PG8_SB(1, 1), b3 + hstep, voffB);
            PG8_WAIT_V(6); PG8_BAR; PG8_MMA(1, 1, At, B1); PG8_BAR;
            }
        }
        if constexpr (ALIGN_EPI) { if (wr == 0) PG8_BAR; }
        if constexpr (!Epi::AFTER_DRAIN) { E(acc, cur, wr, wc, fr, fq); S.done(cur); }
        if (!has_next) break;
#pragma unroll
        for (int a = 0; a < 2; ++a)
#pragma unroll
            for (int b = 0; b < 2; ++b)
#pragma unroll
                for (int m = 0; m < 4; ++m)
#pragma unroll
                    for (int n = 0; n < 2; ++n) acc[a][b][m][n] = (f32x4){0.f, 0.f, 0.f, 0.f};
        cur = nxt; cA = nA; cB = nB; ++ui;
        if constexpr (ALIGN_EPI) { if (wr == 1) PG8_BAR; }
    }
    PG8_WAIT_V(0);
    if constexpr (!ALIGN_EPI) { if (wr == 0) PG8_BAR; }
    PG8_BAR;
    if constexpr (Epi::AFTER_DRAIN) { E.fused(acc, cur, wr, wc, fr, fq, lds, wid, lane); S.done(cur); }
#undef PG8_SA
#undef PG8_SB
#undef PG8_STAGE
#undef PG8_LDA
#undef PG8_LDB
#undef PG8_MMA
#undef PG8_WAIT_V
#undef PG8_WAIT_L
#undef PG8_BAR
#undef PG8_SCHED
}
}
namespace att {
#define ALAS __attribute__((address_space(3)))
typedef unsigned short bf16_t;
typedef short bf16x8 __attribute__((ext_vector_type(8)));
typedef short s16x4 __attribute__((ext_vector_type(4)));
typedef float f32x16 __attribute__((ext_vector_type(16)));
typedef float f32x4 __attribute__((ext_vector_type(4)));
typedef unsigned u32x4 __attribute__((ext_vector_type(4)));
typedef float f32x2_t __attribute__((ext_vector_type(2))); typedef __bf16 bf16x2_t __attribute__((ext_vector_type(2)));
constexpr int SEQ = 8192;
typedef ALAS char* ALAS_char_t;
__device__ __forceinline__ int crow(int r, int hi) { return (r & 3) + 8 * (r >> 2) + 4 * hi; }
#define SBAR() __builtin_amdgcn_sched_barrier(0)
__device__ __forceinline__ void glds16(const void* gsrc, unsigned lds_dst) { unsigned keep;
  asm volatile("s_mov_b32 %0, m0\n\ts_mov_b32 m0, %2\n\ts_nop 0\n\tglobal_load_lds_dwordx4 %1, off\n\ts_mov_b32 m0, %0" : "=&s"(keep) : "v"(gsrc), "s"(lds_dst) : "memory"); }
__device__ __forceinline__ unsigned cvtpk_s(float lo, float hi) { f32x2_t v = {lo, hi}; bf16x2_t b = __builtin_convertvector(v, bf16x2_t); return __builtin_bit_cast(unsigned, b); }
__device__ __forceinline__ float bf2f(short v) { return __uint_as_float(((unsigned)(unsigned short)v) << 16); }
__device__ __forceinline__ unsigned short f2bf(float f) { unsigned u = __builtin_bit_cast(unsigned, f); return (unsigned short)((u + 0x7fffu + ((u >> 16) & 1u)) >> 16); }
#define MFMA32(a, b, c) __builtin_amdgcn_mfma_f32_32x32x16_bf16((a), (b), (c), 0, 0, 0)
template <int NK> __device__ __forceinline__ void qkt(f32x16& p0, f32x16& p1, const ALAS char* kb, const bf16x8* qr, const f32x16& cinit) {
#pragma unroll
  for (int d0 = 0; d0 < NK; ++d0) {
    const bf16x8 b0 = *(const ALAS bf16x8*)(kb + d0 * 2048);
    const bf16x8 b1 = *(const ALAS bf16x8*)(kb + d0 * 2048 + 512);
    if (d0 == 0) { p0 = MFMA32(b0, qr[0], cinit); p1 = MFMA32(b1, qr[0], cinit); }
    else { p0 = MFMA32(b0, qr[d0], p0); p1 = MFMA32(b1, qr[d0], p1); } }
}
__device__ __forceinline__ void pv(f32x16* o, int vb, bf16x8 pa0, bf16x8 pa1, bf16x8 pa2, bf16x8 pa3) {
#pragma unroll
  for (int d0 = 0; d0 < 2; ++d0) { s16x4 lo[4], hi[4];
#pragma unroll
    for (int ks = 0; ks < 4; ++ks) {
      asm volatile("ds_read_b64_tr_b16 %0,%1 offset:%c2" : "=&v"(lo[ks]) : "v"(vb), "i"(d0 * 4096 + ks * 1024) : "memory");
      asm volatile("ds_read_b64_tr_b16 %0,%1 offset:%c2" : "=&v"(hi[ks]) : "v"(vb), "i"(d0 * 4096 + ks * 1024 + 512) : "memory"); }
    asm volatile("s_waitcnt lgkmcnt(0)" ::: "memory"); SBAR();
#define PK(k) (bf16x8){lo[k][0], lo[k][1], lo[k][2], lo[k][3], hi[k][0], hi[k][1], hi[k][2], hi[k][3]}
    o[d0] = MFMA32(pa0, PK(0), o[d0]); o[d0] = MFMA32(pa1, PK(1), o[d0]); o[d0] = MFMA32(pa2, PK(2), o[d0]); o[d0] = MFMA32(pa3, PK(3), o[d0]);
#undef PK
  }
}
__device__ __forceinline__ void pv2(f32x16* o, int vA, int vB, bf16x8 pa0, bf16x8 pa1, bf16x8 pa2, bf16x8 pa3) {
#pragma unroll
  for (int d0 = 0; d0 < 2; ++d0) { s16x4 lo[4], hi[4]; const int vb = d0 ? vB : vA;
#pragma unroll
    for (int ks = 0; ks < 4; ++ks) {
      asm volatile("ds_read_b64_tr_b16 %0,%1 offset:%c2" : "=&v"(lo[ks]) : "v"(vb), "i"(ks * 2048) : "memory");
      asm volatile("ds_read_b64_tr_b16 %0,%1 offset:%c2" : "=&v"(hi[ks]) : "v"(vb), "i"(ks * 2048 + 1024) : "memory"); }
    asm volatile("s_waitcnt lgkmcnt(0)" ::: "memory"); SBAR();
#define PK(k) (bf16x8){lo[k][0], lo[k][1], lo[k][2], lo[k][3], hi[k][0], hi[k][1], hi[k][2], hi[k][3]}
    o[d0] = MFMA32(pa0, PK(0), o[d0]); o[d0] = MFMA32(pa1, PK(1), o[d0]); o[d0] = MFMA32(pa2, PK(2), o[d0]); o[d0] = MFMA32(pa3, PK(3), o[d0]);
#undef PK
  }
}
__device__ __forceinline__ float rowmax(const f32x16& p0, const f32x16& p1) {
  float a = __builtin_fmaxf(p0[0], p1[0]), b = __builtin_fmaxf(p0[1], p1[1]);
#pragma unroll
  for (int r = 2; r < 16; r += 2) { a = __builtin_fmaxf(a, __builtin_fmaxf(p0[r], p1[r])); b = __builtin_fmaxf(b, __builtin_fmaxf(p0[r + 1], p1[r + 1])); }
  const float m = __builtin_fmaxf(a, b);
  auto rr = __builtin_amdgcn_permlane32_swap(__float_as_uint(m), __float_as_uint(m), false, false);
  return __builtin_fmaxf(__uint_as_float(rr[0]), __uint_as_float(rr[1]));
}
__device__ __forceinline__ float max3a(float a, float b, float c) { float r; asm("v_max3_f32 %0, %1, %2, %3" : "=v"(r) : "v"(a), "v"(b), "v"(c)); return r; }
__device__ __forceinline__ float max16a(const f32x16& p) { float a, b;
  asm("v_max3_f32 %0, %2, %3, %4\n\tv_max3_f32 %1, %5, %6, %7\n\tv_max3_f32 %0, %0, %8, %9\n\tv_max3_f32 %1, %1, %10, %11\n\tv_max3_f32 %0, %0, %12, %13\n\tv_max3_f32 %1, %1, %14, %15\n\tv_max3_f32 %0, %0, %16, %17\n\tv_max_f32_e32 %0, %0, %1"
      : "=&v"(a), "=&v"(b) : "v"(p[0]), "v"(p[1]), "v"(p[2]), "v"(p[3]), "v"(p[4]), "v"(p[5]), "v"(p[6]), "v"(p[7]), "v"(p[8]), "v"(p[9]), "v"(p[10]), "v"(p[11]), "v"(p[12]), "v"(p[13]), "v"(p[14]), "v"(p[15]));
  return a; }
__device__ __forceinline__ float rowmax_a(const f32x16& p0, const f32x16& p1) {
  const float a = max16a(p0), b = max16a(p1); float m; asm("v_max_f32_e32 %0, %1, %2" : "=v"(m) : "v"(a), "v"(b));
  auto rr = __builtin_amdgcn_permlane32_swap(__float_as_uint(m), __float_as_uint(m), false, false);
  float q; { const float x = __uint_as_float(rr[0]), y = __uint_as_float(rr[1]); asm("v_max_f32_e32 %0, %1, %2" : "=v"(q) : "v"(x), "v"(y)); }
  return q;
}
#define PKW(P, B) cvtpk_s(P[B], P[B + 1])
__device__ __forceinline__ void store_o(const f32x16* o, bf16_t* Ow, int pitch, ALAS bf16_t* stg, int lane) {
  const int r32 = lane & 31, hi = lane >> 5;
#pragma unroll
  for (int r = 0; r < 16; ++r) { const int orow = crow(r, hi);
#pragma unroll
    for (int d0 = 0; d0 < 2; ++d0) stg[orow * 64 + d0 * 32 + r32] = f2bf(o[d0][r]); }
  asm volatile("s_waitcnt lgkmcnt(0)" ::: "memory");
#pragma unroll
  for (int i = 0; i < 4; ++i) { const int row = i * 8 + (lane >> 3), ch = lane & 7; const u32x4 v = *(const ALAS u32x4*)(stg + row * 64 + ch * 8); *(u32x4*)(Ow + (long)row * pitch + ch * 8) = v; }
  asm volatile("s_waitcnt lgkmcnt(0)" ::: "memory");
}

struct SbConsts { bf16x8 T0, T1, ONES; };
__device__ __forceinline__ void sb_consts(SbConsts& c, int lane) {
  const int r = lane & 31, h = lane >> 5;
#pragma unroll
  for (int j = 0; j < 8; ++j) { const int kin = 8 * (j >> 2) + 4 * h + (j & 3); c.T0[j] = (kin > r) ? (short)0xBF80 : (short)0; c.T1[j] = (16 + kin > r) ? (short)0xBF80 : (short)0; c.ONES[j] = (short)0xBF80; }
}
__device__ __forceinline__ void sb_unit(int b, int h, int qblk, const bf16_t* Q, const bf16_t* __restrict__ K, const bf16_t* __restrict__ V, bf16_t* O, ALAS char* wl, const SbConsts& tc) {
  int tid_ = threadIdx.x; asm volatile("" : "+v"(tid_));
  const int lane = tid_ & 63, r32 = lane & 31, hi = lane >> 5;
  const long rowbase = (long)b * SEQ; const int q0 = qblk * 32;
  const bf16_t* Qw = Q + (rowbase + q0) * 1024 + h * 64;
  const bf16_t* Kh = K + rowbase * 1024 + h * 64; const bf16_t* Vh = V + rowbase * 1024 + h * 64;
  const unsigned kslot = (unsigned)__builtin_amdgcn_readfirstlane((int)(unsigned)(uintptr_t)wl), vslot = kslot + 8192u;
  bf16x8 qr[4];
#pragma unroll
  for (int d0 = 0; d0 < 4; ++d0) qr[d0] = *(const bf16x8*)(Qw + (long)r32 * 1024 + d0 * 16 + hi * 8);
  f32x16 o[2]; o[0] = f32x16{}; o[1] = f32x16{}; float C = 0.f;
  const ALAS char* kp = wl + r32 * 128; const int kg = (r32 >> 1) & 7;
  const int vq = (lane & 15) >> 2;
  const int vbA = (int)vslot + (4 * hi + vq) * 128 + ((vq >> 1) & 1) * 64 + ((lane >> 4) & 1) * 32 + (lane & 3) * 8, vbB = vbA ^ 64;
  const int tdiag = q0 >> 6;
  for (int t = tdiag; t >= 0; --t) {
    { const bf16_t* ks = Kh + (long)(64 * t + (lane >> 3)) * 1024;
#pragma unroll
      for (int p = 0; p < 8; ++p) glds16(ks + (long)(8 * p) * 1024 + (((lane & 7) ^ ((4 * p + (lane >> 4)) & 7)) * 8), kslot + p * 1024);
      const bf16_t* vs = Vh + (long)(64 * t + (lane >> 3)) * 1024 + (((lane & 7) ^ (((lane >> 4) & 1) << 2)) * 8);
#pragma unroll
      for (int p = 0; p < 8; ++p) glds16(vs + (long)(8 * p) * 1024, vslot + p * 1024); }
    asm volatile("s_waitcnt vmcnt(0)" ::: "memory");
    f32x16 y0, y1;
    { const f32x16 z = f32x16{}; bf16x8 kf[8];
#pragma unroll
      for (int d0 = 0; d0 < 4; ++d0) { const int off = ((2 * d0 + hi) ^ kg) << 4; kf[2 * d0] = *(const ALAS bf16x8*)(kp + off); kf[2 * d0 + 1] = *(const ALAS bf16x8*)(kp + off + 4096); }
      SBAR();
#pragma unroll
      for (int d0 = 0; d0 < 4; ++d0) {
        if (d0 == 0) { y0 = MFMA32(kf[0], qr[0], z); y1 = MFMA32(kf[1], qr[0], z); } else { y0 = MFMA32(kf[2 * d0], qr[d0], y0); y1 = MFMA32(kf[2 * d0 + 1], qr[d0], y1); } } }
    if (t == tdiag) { const int qrel = (q0 & 63) + r32;
      asm volatile("" : "+v"(y0), "+v"(y1));
#pragma unroll
      for (int r = 0; r < 16; ++r) { const int kv = 4 * hi + (r & 3) + 8 * (r >> 2); if (kv >= qrel) y0[r] = -1e30f; if (kv + 32 >= qrel) y1[r] = -1e30f; } }
    f32x16 L0, L1;
#pragma unroll
    for (int r = 0; r < 16; ++r) { y0[r] = __builtin_amdgcn_fmed3f(y0[r], -3.0e38f, 64.f); y1[r] = __builtin_amdgcn_fmed3f(y1[r], -3.0e38f, 64.f); }
    SBAR();
#pragma unroll
    for (int r = 0; r < 16; ++r) { L0[r] = __builtin_amdgcn_exp2f(y0[r]); L1[r] = __builtin_amdgcn_exp2f(y1[r]); }
    SBAR();
#pragma unroll
    for (int r = 0; r < 16; ++r) { L0[r] = 1.f + L0[r]; L1[r] = 1.f + L1[r]; }
    SBAR();
#pragma unroll
    for (int r = 0; r < 16; ++r) { L0[r] = __builtin_amdgcn_logf(L0[r]); L1[r] = __builtin_amdgcn_logf(L1[r]); }
    SBAR();
#pragma unroll
    for (int r = 0; r < 16; ++r) { y0[r] = y0[r] - L0[r]; y1[r] = y1[r] - L1[r]; }
    SBAR();
    u32x4 w0, w1, w2, w3;
    w0 = (u32x4){PKW(L0, 0), PKW(L0, 2), PKW(L0, 4), PKW(L0, 6)}; w1 = (u32x4){PKW(L0, 8), PKW(L0, 10), PKW(L0, 12), PKW(L0, 14)};
    w2 = (u32x4){PKW(L1, 0), PKW(L1, 2), PKW(L1, 4), PKW(L1, 6)}; w3 = (u32x4){PKW(L1, 8), PKW(L1, 10), PKW(L1, 12), PKW(L1, 14)};
    f32x16 cv;
#pragma unroll
    for (int r = 0; r < 16; ++r) cv[r] = C;
    f32x16 S0 = MFMA32(tc.T0, __builtin_bit_cast(bf16x8, w0), cv); S0 = MFMA32(tc.T1, __builtin_bit_cast(bf16x8, w1), S0);
    S0 = MFMA32(tc.ONES, __builtin_bit_cast(bf16x8, w2), S0); S0 = MFMA32(tc.ONES, __builtin_bit_cast(bf16x8, w3), S0);
    f32x16 S1 = MFMA32(tc.T0, __builtin_bit_cast(bf16x8, w2), cv); S1 = MFMA32(tc.T1, __builtin_bit_cast(bf16x8, w3), S1);
#pragma unroll
    for (int r = 0; r < 16; ++r) { y0[r] = y0[r] + S0[r]; y1[r] = y1[r] + S1[r]; }
    SBAR();
#pragma unroll
    for (int r = 0; r < 16; ++r) { y0[r] = __builtin_amdgcn_exp2f(y0[r]); y1[r] = __builtin_amdgcn_exp2f(y1[r]); }
    SBAR();
    { const float tot = S0[0] - L0[0]; auto rr = __builtin_amdgcn_permlane32_swap(__float_as_uint(tot), __float_as_uint(tot), false, false); C = __uint_as_float(rr[0]); }
    w0 = (u32x4){PKW(y0, 0), PKW(y0, 2), PKW(y0, 4), PKW(y0, 6)}; w1 = (u32x4){PKW(y0, 8), PKW(y0, 10), PKW(y0, 12), PKW(y0, 14)};
    w2 = (u32x4){PKW(y1, 0), PKW(y1, 2), PKW(y1, 4), PKW(y1, 6)}; w3 = (u32x4){PKW(y1, 8), PKW(y1, 10), PKW(y1, 12), PKW(y1, 14)};
    SBAR(); pv2(o, vbA, vbB, __builtin_bit_cast(bf16x8, w0), __builtin_bit_cast(bf16x8, w1), __builtin_bit_cast(bf16x8, w2), __builtin_bit_cast(bf16x8, w3));
    if (__all(C < -151.f)) break;
  }
  store_o(o, O + (rowbase + q0) * 1024 + h * 64, 1024, (ALAS bf16_t*)wl, lane);
}

constexpr int KSLOT = 12288, VSLOT = 8192, NSLOT = 3;
constexpr int LDS_K = 0, LDS_V = NSLOT * KSLOT, LDS_WS = LDS_V + NSLOT * VSLOT, LDS_OST = LDS_WS + 8 * 64 * 4, LDS_BYTES = LDS_OST + 8 * 4096;
#define WAIT_BAR(N) asm volatile("s_waitcnt vmcnt(" #N ") lgkmcnt(0)\n\ts_barrier" ::: "memory")
template <int THRL> __device__ __forceinline__ void mla_unit(int b, int h, int qb, const bf16_t* QB, const bf16_t* __restrict__ KVB, const bf16_t* __restrict__ KR, const float* __restrict__ CS, bf16_t* O, ALAS char* shm) {
  int tid_ = threadIdx.x; asm volatile("" : "+v"(tid_));
  const int tid = tid_, lane = tid & 63, r32 = lane & 31, hi = lane >> 5; const int wid = __builtin_amdgcn_readfirstlane(tid >> 6);
  const long rowbase = (long)b * SEQ; const int q0 = qb * 256;
  const unsigned lds0 = (unsigned)(uintptr_t)shm;
  ALAS float* wsf = (ALAS float*)(shm + LDS_WS) + wid * 64;
  const int NT = (q0 + 256) / 64;
  const long qrow = rowbase + q0 + wid * 32 + r32;
  bf16x8 qr[6];
  { const bf16_t* Qw = QB + qrow * 1536 + h * 96;
#pragma unroll
    for (int d0 = 0; d0 < 6; ++d0) qr[d0] = *(const bf16x8*)(Qw + d0 * 16 + hi * 8);
    const float* cs = CS + qrow * 32 + 8 * hi;
    const f32x4 c0 = *(const f32x4*)(cs), c1 = *(const f32x4*)(cs + 4), s0 = *(const f32x4*)(cs + 16), s1 = *(const f32x4*)(cs + 20);
#pragma unroll
    for (int j = 0; j < 8; ++j) { const float c = j < 4 ? c0[j & 3] : c1[j & 3], s = j < 4 ? s0[j & 3] : s1[j & 3];
      const float t1 = bf2f(qr[4][j]), t2 = bf2f(qr[5][j]); qr[4][j] = (short)f2bf(t1 * c - t2 * s); qr[5][j] = (short)f2bf(t2 * c + t1 * s); } }
  const bf16_t* ksrc = KVB + (rowbase + 8 * wid + (lane >> 3)) * 2048 + h * 128 + (((lane & 7) ^ ((4 * wid + (lane >> 4)) & 7)) * 8);
  const bf16_t* rsrc = KR + (rowbase + 16 * (wid & 3) + (lane >> 2)) * 32 + (((lane & 3) ^ ((lane >> 4) & 3)) * 8);
  const bf16_t* vsrc = KVB + (rowbase + 8 * wid + (lane >> 3)) * 2048 + h * 128 + 64 + (((lane & 7) ^ (((lane >> 4) & 1) << 2)) * 8);
  const unsigned kdst = lds0 + LDS_K + wid * 1024, rdst = lds0 + LDS_K + 8192 + (wid & 3) * 1024, vdst = lds0 + LDS_V + wid * 1024;
  const bool ropew = wid < 4;
#define DMA(t, s) do { glds16(ksrc + (long)(t) * 64 * 2048, (unsigned)__builtin_amdgcn_readfirstlane((int)(kdst + (s) * KSLOT))); \
    if (ropew) glds16(rsrc + (long)(t) * 64 * 32, (unsigned)__builtin_amdgcn_readfirstlane((int)(rdst + (s) * KSLOT))); \
    glds16(vsrc + (long)(t) * 64 * 2048, (unsigned)__builtin_amdgcn_readfirstlane((int)(vdst + (s) * VSLOT))); } while (0)
  asm volatile("s_waitcnt vmcnt(0)" ::: "memory");
  DMA(0, 0); DMA(1, 1);
  float mhat = 0.f; f32x16 o[2]; o[0] = f32x16{}; o[1] = f32x16{}; f32x16 negm = f32x16{}; f32x16 lacc = f32x16{};
  bf16x8 ones; { _Pragma("unroll") for (int j = 0; j < 8; ++j) ones[j] = (short)0x3F80; }
  bool first = true;
  const ALAS char* kp0 = (const ALAS char*)shm + LDS_K + r32 * 128; const ALAS char* rp0 = (const ALAS char*)shm + LDS_K + 8192 + r32 * 64;
  const int kg = (r32 >> 1) & 7, rg = (r32 >> 2) & 3;
  const int vq = (lane & 15) >> 2; const int vbA0 = (int)(lds0 + LDS_V) + (4 * hi + vq) * 128 + ((vq >> 1) & 1) * 64 + ((lane >> 4) & 1) * 32 + (lane & 3) * 8;
  int slot = 0, slot2 = 2;
  for (int t = 0; t < NT; ++t) {
    if (t + 1 >= NT) WAIT_BAR(0); else if (ropew) WAIT_BAR(3); else WAIT_BAR(2);
    if (t + 2 < NT) DMA(t + 2, slot2);
    const int jb = t - (NT - 4);
    if (jb <= (wid >> 1)) {
      f32x16 c0, c1;
      { const ALAS char* kp_ = kp0 + slot * KSLOT; const ALAS char* rp_ = rp0 + slot * KSLOT;
        bf16x8 kf[12];
#pragma unroll
        for (int d0 = 0; d0 < 6; ++d0) {
          if (d0 < 4) { const int off = ((2 * d0 + hi) ^ kg) << 4; kf[2 * d0] = *(const ALAS bf16x8*)(kp_ + off); kf[2 * d0 + 1] = *(const ALAS bf16x8*)(kp_ + off + 4096); }
          else { const int off = ((2 * (d0 - 4) + hi) ^ rg) << 4; kf[2 * d0] = *(const ALAS bf16x8*)(rp_ + off); kf[2 * d0 + 1] = *(const ALAS bf16x8*)(rp_ + off + 2048); } }
        SBAR();
#pragma unroll
        for (int d0 = 0; d0 < 6; ++d0) {
          if (d0 == 0) { c0 = MFMA32(kf[0], qr[0], negm); c1 = MFMA32(kf[1], qr[0], negm); } else { c0 = MFMA32(kf[2 * d0], qr[d0], c0); c1 = MFMA32(kf[2 * d0 + 1], qr[d0], c1); } } }
      asm volatile("s_nop 15\n\ts_nop 7" : "+v"(c0), "+v"(c1));
      const float rm = rowmax_a(c0, c1);
      if (first || __any(rm > (float)THRL)) {
        const float dl = first ? rm : __builtin_fmaxf(rm, 0.f); mhat += dl;
#pragma unroll
        for (int r = 0; r < 16; ++r) { c0[r] -= dl; c1[r] -= dl; negm[r] = -mhat; }
        if (!first) { const float f = __builtin_amdgcn_exp2f(-dl); if (hi == 0) wsf[r32] = f;
          asm volatile("s_waitcnt lgkmcnt(0)" ::: "memory");
#pragma unroll
          for (int d = 0; d < 2; ++d)
#pragma unroll
            for (int r = 0; r < 16; ++r) o[d][r] *= wsf[crow(r, hi)];
#pragma unroll
          for (int r = 0; r < 16; ++r) lacc[r] *= wsf[crow(r, hi)]; }
        first = false; }
#pragma unroll
      for (int r = 0; r < 16; ++r) { c0[r] = __builtin_amdgcn_exp2f(c0[r]); c1[r] = __builtin_amdgcn_exp2f(c1[r]); }
      u32x4 w0, w1, w2, w3;
      w0 = (u32x4){PKW(c0, 0), PKW(c0, 2), PKW(c0, 4), PKW(c0, 6)}; w1 = (u32x4){PKW(c0, 8), PKW(c0, 10), PKW(c0, 12), PKW(c0, 14)};
      w2 = (u32x4){PKW(c1, 0), PKW(c1, 2), PKW(c1, 4), PKW(c1, 6)}; w3 = (u32x4){PKW(c1, 8), PKW(c1, 10), PKW(c1, 12), PKW(c1, 14)};
      SBAR(); pv2(o, vbA0 + slot * VSLOT, (vbA0 + slot * VSLOT) ^ 64, __builtin_bit_cast(bf16x8, w0), __builtin_bit_cast(bf16x8, w1), __builtin_bit_cast(bf16x8, w2), __builtin_bit_cast(bf16x8, w3));
      lacc = MFMA32(__builtin_bit_cast(bf16x8, w0), ones, lacc); lacc = MFMA32(__builtin_bit_cast(bf16x8, w1), ones, lacc); lacc = MFMA32(__builtin_bit_cast(bf16x8, w2), ones, lacc); lacc = MFMA32(__builtin_bit_cast(bf16x8, w3), ones, lacc);
    }
    slot = (slot == 2) ? 0 : slot + 1; slot2 = (slot2 == 2) ? 0 : slot2 + 1;
  }
#undef DMA
#pragma unroll
  for (int r = 0; r < 16; ++r) { const float rl = __builtin_amdgcn_rcpf(lacc[r]); o[0][r] *= rl; o[1][r] *= rl; }
  store_o(o, O + (rowbase + q0 + wid * 32) * 1024 + h * 64, 1024, (ALAS bf16_t*)(shm + LDS_OST) + wid * 2048, lane);
  asm volatile("s_waitcnt lgkmcnt(0)\n\ts_barrier" ::: "memory");
}
#undef WAIT_BAR
#undef PKW
#undef SBAR
}
#define GAS __attribute__((address_space(1)))
#define LAS __attribute__((address_space(3)))
typedef unsigned short bf16;
typedef unsigned v4u __attribute__((ext_vector_type(4)));
typedef float f32x4 __attribute__((ext_vector_type(4)));
typedef short bf16x8 __attribute__((ext_vector_type(8)));
typedef GAS unsigned gu32;
typedef GAS unsigned long long gu64;
#define RLX_AGENT __ATOMIC_RELAXED, __HIP_MEMORY_SCOPE_AGENT
#define LDS_WAIT() asm volatile("s_waitcnt lgkmcnt(0)" ::: "memory")
#define VM_WAIT() asm volatile("s_waitcnt vmcnt(0)" ::: "memory")
__device__ __forceinline__ unsigned long long rt() { return __builtin_amdgcn_s_memrealtime(); }
__device__ __forceinline__ unsigned f2bf(float f) { unsigned u = __builtin_bit_cast(unsigned, f); return (u + 0x7fffu + ((u >> 16) & 1u)) >> 16; }
__device__ __forceinline__ unsigned pk2(float lo, float hi) { return f2bf(lo) | (f2bf(hi) << 16); }

#define XB_TMO      128
#define XB_XCNT(j)  (256  + 64 * (j))
#define XB_XSUB(j)  (1280 + 64 * (j))
#define XB_XGEN(j)  (2304 + 64 * (j))
#define XB_TOP      3328
#define XB_TOPGEN   3392
#define XCD_BAR_WORDS 3456
#define XB_SPIN_CAP (1u << 18)

__device__ __forceinline__ unsigned xb_ld(unsigned* p)              { return __hip_atomic_load(p, __ATOMIC_RELAXED, __HIP_MEMORY_SCOPE_AGENT); }
__device__ __forceinline__ unsigned xb_add(unsigned* p, unsigned v) { return __hip_atomic_fetch_add(p, v, __ATOMIC_RELAXED, __HIP_MEMORY_SCOPE_AGENT); }
__device__ __forceinline__ unsigned xb_xcc_id() { return (unsigned)__builtin_amdgcn_s_getreg((3 << 11) | 20) & 0xFu; }
#define XB_SPIN(cond, bar) do { unsigned _sp = 0; while (cond) { __builtin_amdgcn_s_sleep(1); \
    if ((++_sp & 255u) == 0u) { if (xb_ld(&(bar)[XB_TMO])) break; if (_sp > XB_SPIN_CAP) { atomicAdd(&(bar)[XB_TMO], 1u); break; } } } } while (0)

struct XcdBarrier {
    unsigned* bar; unsigned x;
    volatile LAS unsigned* st;
};

__device__ __forceinline__ XcdBarrier xcd_barrier_post(unsigned* bar, volatile LAS unsigned* st) {
    XcdBarrier b; b.bar = bar; b.x = xb_xcc_id(); b.st = st;
    if (threadIdx.x == 0) (void)xb_add(&bar[XB_XCNT(b.x)], 1u);
    return b;
}
__device__ __forceinline__ void xcd_barrier_complete(unsigned* bar, unsigned x, unsigned& nloc, unsigned& nx) {
    const unsigned G = gridDim.x * gridDim.y * gridDim.z;
    unsigned sum, cnt, mine, sp = 0u;
    for (;;) {
        sum = 0u; cnt = 0u; mine = 0u;
#pragma unroll
        for (unsigned j = 0; j < 16; ++j) { const unsigned c = xb_ld(&bar[XB_XCNT(j)]); sum += c; cnt += (c > 0u) ? 1u : 0u; mine = (j == x) ? c : mine; }
        if (sum == G) break;
        __builtin_amdgcn_s_sleep(1);
        if ((++sp & 255u) == 0u) { if (xb_ld(&bar[XB_TMO])) break; if (sp > XB_SPIN_CAP) { atomicAdd(&bar[XB_TMO], 1u); break; } }
    }
    nloc = mine > 0u ? mine : 1u; nx = cnt > 0u ? cnt : 1u;
}

__device__ __forceinline__ void xcd_barrier(const XcdBarrier& b) {
    asm volatile("s_waitcnt vmcnt(0)" ::: "memory");
    __syncthreads();
    if (threadIdx.x == 0) {
        unsigned* bar = b.bar;
        __builtin_amdgcn_s_waitcnt(0);
        unsigned nloc = b.st[0], nx = b.st[1];
        if (nloc == 0u) { xcd_barrier_complete(bar, b.x, nloc, nx); b.st[0] = nloc; b.st[1] = nx; }
        const unsigned old = xb_add(&bar[XB_XSUB(b.x)], 1u);
        const unsigned gen = old / nloc;
        if (old + 1u == (gen + 1u) * nloc) {
            __builtin_amdgcn_fence(__ATOMIC_RELEASE, "agent");
            asm volatile("s_waitcnt vmcnt(0)" ::: "memory");
            const unsigned og = xb_add(&bar[XB_TOP], 1u);
            const unsigned tg = og / nx;
            if (og + 1u == (tg + 1u) * nx) xb_add(&bar[XB_TOPGEN], 1u);
            else XB_SPIN(xb_ld(&bar[XB_TOPGEN]) == tg, bar);
            __builtin_amdgcn_fence(__ATOMIC_ACQUIRE, "agent");
            xb_add(&bar[XB_XGEN(b.x)], 1u);
            asm volatile("s_waitcnt vmcnt(0)" ::: "memory");
        } else {
            XB_SPIN(xb_ld(&bar[XB_XGEN(b.x)]) == gen, bar);
            __builtin_amdgcn_fence(__ATOMIC_ACQUIRE, "agent");
            asm volatile("s_waitcnt vmcnt(0)" ::: "memory");
        }
    }
    __syncthreads();
}
constexpr int NWAVES = 8;
constexpr int SEQ = 8192, M = 2 * SEQ, D = 1024, FF = 4096;
constexpr float NORM_EPS = 1e-6f;
constexpr float LOG2E = 1.4426950408889634f;
constexpr float C2_SB = 0.125f * LOG2E;
constexpr float C2_MLA = 0.10206207261596575f * LOG2E;
constexpr unsigned MB = 1u << 20, KB = 1u << 10;
constexpr unsigned O_CTL = 0, CTL_ZERO_BYTES = 16 * KB;
constexpr unsigned O_RS = 64 * KB, N_RS = 11;
constexpr unsigned O_WQKV = 2 * MB, O_WOSB = 14 * MB, O_W1A = 18 * MB, O_W2A = 34 * MB, O_W1B = 50 * MB, O_W2B = 66 * MB, O_WD0 = 82 * MB,
                   O_WD1 = O_WD0 + 1536 * KB, O_WUKV = O_WD1 + 1 * MB,
                   O_WUQ = O_WUKV + 1 * MB, O_WOM = O_WUQ + 2304 * KB;
constexpr unsigned O_XN = 92 * MB;
constexpr unsigned O_Q = 124 * MB, O_K = 156 * MB, O_V = 188 * MB, O_OA = 220 * MB;
constexpr unsigned O_H = 124 * MB;
constexpr unsigned O_KVB = 124 * MB, O_KR = 188 * MB, O_DQ = 189 * MB, O_QB = 189 * MB, O_H2 = 189 * MB, O_CQ = 237 * MB, O_CKV = 2 * MB  , O_OB = 18 * MB  ;
constexpr unsigned O_CS = 253 * MB;
constexpr size_t WS_NEED = (size_t)255 * MB;
static_assert(O_WOM + 4 * MB <= O_XN, "weights");

enum { OP_GB = 0, OP_GR2 = 1, OP_GRES = 2, OP_GLAT = 3, OP_ATTA = 4, OP_ATTB = 5, OP_NORM = 6, OP_LAT = 7, OP_FINAL = 8 };
struct Ph { int op; unsigned a, b, c; int N, K, ldc, p0; float s0, s1; int nosync; int rs; };
#define PH_A_LAYER(l) \
  {OP_GB, O_XN, O_WQKV + (l) * 6 * MB, O_Q, 3072, 1024, 1024, 1024, C2_SB, 1.f, 0, ((l) == 0 ? 0 : 2)}, \
  {OP_ATTA, 0, 0, 0, 0, 0, 0, 0, 0.f, 0.f, 0, 0}, \
  {OP_GRES, O_OA, O_WOSB + (l) * 2 * MB, 0, 1024, 1024, 1024, 34 + ((l) == 0 ? 1 : 4), 0.f, 0.f, 0, 1 + 2 * (l)}, \
  {OP_GR2, O_XN, O_W1A + (l) * 8 * MB, O_H, 4096, 1024, 4096, 0, 1.f, 1.f, 0, 1 + 2 * (l)}, \
  {OP_GRES, O_H, O_W2A + (l) * 8 * MB, 0, 1024, 4096, 1024, 38, 0.f, 0.f, 0, 2 + 2 * (l)}
__constant__ Ph prog[] = {
  PH_A_LAYER(0), PH_A_LAYER(1),
  {OP_GLAT, O_XN, O_WD0, 6, 768, 1024, 7, 288, 0.f, 0.f, 0, 4},
  {OP_GB, O_CKV, O_WUKV, O_KVB, 2048, 256, 2048, 0, 1.f, 1.f, 1, 6},
  {OP_GB, O_CQ, O_WUQ, O_QB, 1536, 384, 1536, 0, 1.f, C2_MLA, 0, 7},
  {OP_ATTB, 0, 0, 0, 0, 0, 0, 0, 0.f, 0.f, 0, 0},
  {OP_GRES, O_OB, O_WOM, 0, 1024, 1024, 1024, 38, 0.f, 0.f, 0, 9},
  {OP_GR2, O_XN, O_W1B, O_H2, 2048, 1024, 2048, 0, 1.f, 1.f, 0, 9},
  {OP_GRES, O_H2, O_W2B, 0, 1024, 2048, 1024, 54, 0.f, 0.f, 0, 0},
  {OP_GR2, O_XN, O_W1B + 4 * MB, O_H2, 2048, 1024, 2048, 0, 1.f, 1.f, 0, 9},
  {OP_GRES, O_H2, O_W2B + 4 * MB, 0, 1024, 2048, 1024, 42, 0.f, 0.f, 0, 5},
  {OP_GLAT, O_XN, O_WD1, 0, 512, 1024, 8, 0, 0.f, 0.f, 0, 5},
  {OP_GB, O_CQ, O_WUQ + 1152 * KB, O_QB, 1536, 384, 1536, 0, 1.f, C2_MLA, 0, 8},
  {OP_ATTB, 0, 0, 0, 0, 0, 0, 0, 0.f, 0.f, 0, 0},
  {OP_GRES, O_OB, O_WOM + 2 * MB, 0, 1024, 1024, 1024, 38, 0.f, 0.f, 0, 10},
  {OP_GR2, O_XN, O_W1B + 8 * MB, O_H, 4096, 1024, 4096, 0, 1.f, 1.f, 0, 10},
  {OP_GRES, O_H, O_W2B + 8 * MB, 0, 1024, 4096, 1024, 38, 0.f, 0.f, 0, 11},
  {OP_FINAL, 0, 0, 0, 0, 0, 0, 0, 0.f, 0.f, 1, 0},
};
constexpr int NPH = sizeof(prog) / sizeof(Ph);

constexpr int RING_OFF = 0, RING_BYTES = 131072;
constexpr int LDSCTL_OFF = RING_BYTES, MISC_OFF = LDSCTL_OFF + 320;
constexpr int LDS_BYTES = 147456;
static_assert(att::LDS_BYTES <= RING_BYTES, "attention LDS");
__device__ __forceinline__ float wave_sum(float v) {
#pragma unroll
    for (int o = 1; o < 64; o <<= 1) v += __shfl_xor(v, o);
    return v;
}
__device__ __forceinline__ unsigned cvtpk2(float lo, float hi) { unsigned r; asm("v_cvt_pk_bf16_f32 %0, %1, %2" : "=v"(r) : "v"(lo), "v"(hi)); return r; }
struct P0Job { const float* W; const float* g; int K, N; bf16* WT; int row_off, item; };
#define P0_LOAD(J, wv) do { const int nblk_ = (J).N / 32, k0_ = 64 * ((J).item / nblk_), n0_ = 32 * ((J).item % nblk_);        \
    _Pragma("unroll") for (int i = 0; i < 8; ++i) (wv)[i] = __builtin_nontemporal_load((const GAS f32x4*)((J).W + (size_t)(k0_ + 8 * i + (lane >> 3)) * (J).N + n0_ + 4 * (lane & 7))); } while (0)
__device__ __forceinline__ void p0_finish(const P0Job& J, LAS float* scr, int lane) {
    const int nblk = J.N / 32, k0 = 64 * (J.item / nblk), n0 = 32 * (J.item % nblk);
    const int c = lane & 7;
    f32x4 g0 = (f32x4){1.f, 1.f, 1.f, 1.f}, g1 = g0;
    if (J.g) { g0 = *(const GAS f32x4*)(J.g + k0 + 8 * c); g1 = *(const GAS f32x4*)(J.g + k0 + 8 * c + 4); }
#pragma unroll
    for (int j = 0; j < 4; ++j) { const int n = (lane >> 3) + 8 * j; const LAS float* s = scr + (8 * c) * 33 + n;
        v4u o; o.x = cvtpk2(s[0 * 33] * g0.x, s[1 * 33] * g0.y); o.y = cvtpk2(s[2 * 33] * g0.z, s[3 * 33] * g0.w); o.z = cvtpk2(s[4 * 33] * g1.x, s[5 * 33] * g1.y); o.w = cvtpk2(s[6 * 33] * g1.z, s[7 * 33] * g1.w);
        *(GAS v4u*)(J.WT + (size_t)(J.row_off + n0 + n) * J.K + k0 + 8 * c) = o; }
    LDS_WAIT(); asm volatile("" ::: "memory");
}
template <int NR, int MODE> __device__ __forceinline__ void rms_rows(const float* xrow, void* orow, const float* gain, int lane) {
    f32x4 v[NR][4]; float s2[NR];
#pragma unroll
    for (int r = 0; r < NR; ++r) { const GAS f32x4* xr = (const GAS f32x4*)(xrow + (size_t)r * D) + lane;
#pragma unroll
        for (int j = 0; j < 4; ++j) v[r][j] = xr[64 * j]; }
#pragma unroll
    for (int r = 0; r < NR; ++r) { float t = 0.f;
#pragma unroll
        for (int j = 0; j < 4; ++j) t += (v[r][j].x * v[r][j].x + v[r][j].y * v[r][j].y) + (v[r][j].z * v[r][j].z + v[r][j].w * v[r][j].w);
        s2[r] = t; }
#pragma unroll
    for (int o = 1; o < 64; o <<= 1) {
#pragma unroll
        for (int r = 0; r < NR; ++r) s2[r] += __shfl_xor(s2[r], o); }
#pragma unroll
    for (int r = 0; r < NR; ++r) { const float rr = 1.f / sqrtf(s2[r] * (1.f / D) + NORM_EPS);
        if (MODE == 0) { GAS unsigned long long* o8 = (GAS unsigned long long*)((bf16*)orow + (size_t)r * D) + lane;
#pragma unroll
            for (int j = 0; j < 4; ++j) o8[64 * j] = (unsigned long long)cvtpk2(v[r][j].x * rr, v[r][j].y * rr) | ((unsigned long long)cvtpk2(v[r][j].z * rr, v[r][j].w * rr) << 32); }
        else { GAS f32x4* of = (GAS f32x4*)((float*)orow + (size_t)r * D) + lane;
#pragma unroll
            for (int j = 0; j < 4; ++j) { const f32x4 gg = *((const GAS f32x4*)gain + lane + 64 * j); of[64 * j] = v[r][j] * rr * gg; } } }
}

#ifndef REP_ATTA
#define REP_ATTA 1
#endif
#ifndef REP_P0
#define REP_P0 1
#endif
#ifndef REP_GR2
#define REP_GR2 1
#endif
#ifndef REP_ATTB
#define REP_ATTB 1
#endif
#ifndef PROBE_MODE
#define PROBE_MODE 0
#endif
struct Args { const float* in[17]; float* out; unsigned char* ws; };
__global__ void __launch_bounds__(NWAVES * 64, 2) fwd(Args args) {
    extern __shared__ __attribute__((aligned(16))) unsigned char lds[];
    LAS unsigned char* L = (LAS unsigned char*)lds;
    volatile LAS unsigned* MISC = (volatile LAS unsigned*)(L + MISC_OFF);
    const int tid = threadIdx.x, lane = tid & 63, wave = __builtin_amdgcn_readfirstlane(tid >> 6);
    const int G = gridDim.x; const int bx = blockIdx.x; const int vcu = (G % 8 == 0) ? (bx % 8) * (G / 8) + bx / 8 : bx;
    unsigned char* ws = args.ws;
    for (int u = tid; u < (LDS_BYTES - LDSCTL_OFF) / 4; u += NWAVES * 64) ((LAS unsigned*)(L + LDSCTL_OFF))[u] = 0u;
    __syncthreads();
    XcdBarrier bar = xcd_barrier_post((unsigned*)(ws + O_CTL), MISC + 8);
    const int gw = vcu * NWAVES + wave, NGW = G * NWAVES;
    float* X = args.out;

    for (int rep0_ = 0; rep0_ < REP_P0; ++rep0_)
    {
        LAS float* scr = (LAS float*)(L + RING_OFF + wave * 16384);
        const float* attn_norm = args.in[2]; const float* mlp_norm = args.in[3];
#define P0_TRY(Wp, gp, K_, N_, WTo, roff) { const int items_ = ((K_) / 64) * ((N_) / 32); if (!hit_ && r_ < items_) { J_.W = (Wp); J_.g = (gp); J_.K = (K_); J_.N = (N_); J_.WT = (bf16*)(ws + (WTo)); J_.row_off = (roff); J_.item = r_; hit_ = true; } r_ -= items_; }
#define P0_DECODE(id, J) do { P0Job& J_ = (J); int r_ = (id); bool hit_ = false; \
        for (int l = 0; l < 4; ++l) { P0_TRY(args.in[14] + (size_t)l * D * FF, mlp_norm + l * D, D, FF, (l < 2 ? O_W1A + l * 8 * MB : O_W1B + (l - 2) * 8 * MB), 0) \
            if (l != 2) P0_TRY(args.in[15] + (size_t)l * FF * D, (const float*)nullptr, FF, D, (l < 2 ? O_W2A + l * 8 * MB : O_W2B + (l - 2) * 8 * MB), 0) \
            else { P0_TRY(args.in[15] + (size_t)l * FF * D, (const float*)nullptr, 2048, D, O_W2B, 0) \
                   P0_TRY(args.in[15] + (size_t)l * FF * D + (size_t)2048 * D, (const float*)nullptr, 2048, D, O_W2B + 4 * MB, 0) } } \
        for (int l = 0; l < 2; ++l) { P0_TRY(args.in[4] + (size_t)l * D * 3072, attn_norm + l * D, D, 3072, O_WQKV + l * 6 * MB, 0) \
            P0_TRY(args.in[5] + (size_t)l * D * D, (const float*)nullptr, D, D, O_WOSB + l * 2 * MB, 0) \
            P0_TRY(args.in[12] + (size_t)l * 384 * 1536, args.in[11] + l * 384, 384, 1536, O_WUQ + l * 1152 * KB, 0) \
            P0_TRY(args.in[13] + (size_t)l * D * D, (const float*)nullptr, D, D, O_WOM + l * 2 * MB, 0) } \
        P0_TRY(args.in[7], args.in[6], D, 288, O_WD0, 0) \
        P0_TRY(args.in[10], attn_norm + 2 * D, D, 384, O_WD0, 288) \
        P0_TRY(args.in[10] + (size_t)D * 384, attn_norm + 3 * D, D, 384, O_WD1, 0) \
        P0_TRY(args.in[9], args.in[8], 256, 2048, O_WUKV, 0) } while (0)
        constexpr int P0_TOTAL = 4 * 2048 + 4 * 2048 + 2 * (1536 + 512 + 288 + 512) + 144 + 192 + 192 + 256;
        if (gw < P0_TOTAL) {
            P0Job J0, J1; f32x4 wv[8];
            int id = gw; P0_DECODE(id, J0); P0_LOAD(J0, wv);
            for (;;) {
                const int idn = id + NGW; const bool more = idn < P0_TOTAL;
#pragma unroll
                for (int i = 0; i < 8; ++i) { LAS float* d_ = scr + (8 * i + (lane >> 3)) * 33 + 4 * (lane & 7); d_[0] = wv[i].x; d_[1] = wv[i].y; d_[2] = wv[i].z; d_[3] = wv[i].w; }
                LDS_WAIT(); asm volatile("" ::: "memory");
                if (more) { P0_DECODE(idn, J1); P0_LOAD(J1, wv); }
                p0_finish(J0, scr, lane);
                if (!more) break;
                J0 = J1; id = idn;
            }
        }
#undef P0_TRY
#undef P0_DECODE
        for (int i = gw * 64 + lane; i < 224 * 128; i += NGW * 64) { const int row = i >> 7, c16 = i & 127;
            bf16* dst = row < 96 ? (bf16*)(ws + O_WD0) + (size_t)(672 + row) * D : (bf16*)(ws + O_WD1) + (size_t)(384 + row - 96) * D;
            *(GAS v4u*)(dst + c16 * 8) = (v4u){0u, 0u, 0u, 0u}; }
        for (int i = gw * 64 + lane; i < N_RS * M / 2; i += NGW * 64) *((GAS f32x4*)(ws + O_RS) + i) = (f32x4){0.f, 0.f, 0.f, 0.f};
        { const int* pos = (const int*)args.in[1]; float* CS = (float*)(ws + O_CS);
          for (int i = gw * 64 + lane; i < M * 16; i += NGW * 64) { const int m = i >> 4, k = i & 15;
              const double bs = (k & 3) == 0 ? 1.0 : (k & 3) == 1 ? 0.5623413251903491 : (k & 3) == 2 ? 0.31622776601683794 : 0.1778279410038923;
              const double sc = (k >> 2) == 0 ? 1.0 : (k >> 2) == 1 ? 0.1 : (k >> 2) == 2 ? 0.01 : 0.001;
              const float inv = (float)(bs * sc); const float ang = (float)pos[m] * inv;
              const double rev = (double)ang * 0.15915494309189535; const float fr = (float)(rev - __builtin_rint(rev));
              CS[m * 32 + k] = __builtin_amdgcn_cosf(fr); CS[m * 32 + 16 + k] = __builtin_amdgcn_sinf(fr); } }
        for (int m = 4 * gw; m < M; m += 4 * NGW) rms_rows<4, 0>(args.in[0] + (size_t)m * D, (bf16*)(ws + O_XN) + (size_t)m * D, nullptr, lane);
    }
    if (__builtin_expect(ws == nullptr, 0)) cg::this_grid().sync();
    xcd_barrier(bar);

    const int lane0 = lane;
    for (int ph = 0; ph < NPH; ++ph) {
        const int op = prog[ph].op;
        int lane = lane0; asm volatile("" : "+v"(lane));
        if (op <= OP_GLAT) {
#ifndef NO_GEMM
            pg8::Gemm g{(const bf16*)(ws + prog[ph].a), (const bf16*)(ws + prog[ph].b), M, prog[ph].N, prog[ph].K};
            pg8::StaticOrder S; S.init(M, prog[ph].N, G, bx);
            const int rsi = prog[ph].rs; pg8::rs_t* rsp = rsi ? (pg8::rs_t*)(ws + O_RS) + (size_t)(rsi - 1) * M : nullptr;
            if (op == OP_GB) { pg8::EpiBf16<0> E{(bf16*)(ws + prog[ph].c), prog[ph].ldc, prog[ph].p0, (size_t)M * 1024, prog[ph].s0, prog[ph].s1, rsp, 1.f / (float)prog[ph].K};
                pg8::gemm_phase<pg8::EpiBf16<0>, pg8::StaticOrder, true, true>(L + RING_OFF, g, S, E); }
            else if (op == OP_GR2) { for (int rep_ = 1; rep_ < REP_GR2; ++rep_) { pg8::EpiBf16<2> E{(bf16*)(ws + prog[ph].c), prog[ph].ldc, 0, 0, 1.f, 1.f, rsp, 1.f / 1024.f};
                pg8::gemm_phase<pg8::EpiBf16<2>, pg8::StaticOrder, true, true>(L + RING_OFF, g, S, E); }
                pg8::EpiBf16<2> E{(bf16*)(ws + prog[ph].c), prog[ph].ldc, 0, 0, 1.f, 1.f, rsp, 1.f / 1024.f};
                pg8::gemm_phase<pg8::EpiBf16<2>, pg8::StaticOrder, true, true>(L + RING_OFF, g, S, E); }
            else if (op == OP_GRES) { const int fl = prog[ph].p0;
                bf16* XNp = (bf16*)(ws + O_XN); bf16* XN2p = (bf16*)(ws + O_OB);
                pg8::EpiF32<true> E{(fl & 1) ? args.in[0] : X, (fl & 2) ? nullptr : X, prog[ph].ldc, (fl & 32) ? ((fl & 16) ? XN2p : XNp) : nullptr, rsp, (fl & 4) ? XNp : (fl & 8) ? XN2p : nullptr};
                pg8::gemm_phase<pg8::EpiF32<true>, pg8::StaticOrder, true, true>(L + RING_OFF, g, S, E); }
            else { pg8::rs_t* rsb = (pg8::rs_t*)(ws + O_RS); const int ik = (int)prog[ph].c, iq = prog[ph].ldc;
                pg8::EpiLat E{rsp, prog[ph].p0, (bf16*)(ws + O_CKV), (bf16*)(ws + O_KR), (bf16*)(ws + O_CQ), ik ? rsb + (size_t)(ik - 1) * M : nullptr, rsb + (size_t)(iq - 1) * M, (const float*)(ws + O_CS)};
                pg8::gemm_phase<pg8::EpiLat, pg8::StaticOrder, true, true>(L + RING_OFF, g, S, E); }
#endif
        } else if (op == OP_ATTA) {
            att::ALAS_char_t wl = (att::ALAS_char_t)(L + RING_OFF + wave * 16384);
            att::SbConsts tc; att::sb_consts(tc, lane);
#ifndef NO_ATTA
            for (int rep_ = 0; rep_ < REP_ATTA; ++rep_)
            for (int u = gw; u < 32 * 256; u += NGW) { const int bh = u >> 8, qblk = u & 255;
                att::sb_unit(bh >> 4, bh & 15, qblk, (const bf16*)(ws + O_Q), (const bf16*)(ws + O_K), (const bf16*)(ws + O_V), (bf16*)(ws + O_OA), wl, tc); }
#endif
        } else if (op == OP_ATTB) {
#ifndef NO_ATTB
            for (int rep_ = 0; rep_ < REP_ATTB; ++rep_)
            for (int i = 0; ; ++i) { int bh, qb;
                if (G == 256) { if (i >= 4) break; const int c = vcu & 31; bh = (vcu >> 5) * 4 + i; qb = (i & 1) ? 31 - c : c; }
                else { const int id = vcu + i * G; if (id >= 1024) break; bh = id & 31; qb = 31 - (id >> 5); }
                att::mla_unit<8>(bh >> 4, bh & 15, qb, (const bf16*)(ws + O_QB), (const bf16*)(ws + O_KVB), (const bf16*)(ws + O_KR), (const float*)(ws + O_CS), (bf16*)(ws + O_OB), (att::ALAS_char_t)(L + RING_OFF)); }
#endif
        } else if (op == OP_NORM) {
            for (int m = 4 * gw; m < M; m += 4 * NGW) rms_rows<4, 0>(X + (size_t)m * D, (bf16*)(ws + O_XN) + (size_t)m * D, nullptr, lane);
        } else {
            const float* gfin = args.in[16]; const bf16* XB = (const bf16*)(ws + O_XN); const pg8::rs_t* rsf = (const pg8::rs_t*)(ws + O_RS) + (size_t)10 * M;
            f32x4 gg[4];
#pragma unroll
            for (int j = 0; j < 2; ++j) { gg[2 * j] = *(const GAS f32x4*)(gfin + 512 * j + 8 * lane); gg[2 * j + 1] = *(const GAS f32x4*)(gfin + 512 * j + 8 * lane + 4); }
            for (int m = 4 * gw; m < M; m += 4 * NGW) { v4u xv[4][2]; float rv[4];
#pragma unroll
                for (int r = 0; r < 4; ++r) { xv[r][0] = *(const GAS v4u*)(XB + (size_t)(m + r) * D + 8 * lane); xv[r][1] = *(const GAS v4u*)(XB + (size_t)(m + r) * D + 512 + 8 * lane); rv[r] = pg8::rs_get(rsf + m + r); }
#pragma unroll
                for (int r = 0; r < 4; ++r) { const float rr = 1.f / sqrtf(rv[r] * (1.f / D) + NORM_EPS);
#pragma unroll
                    for (int j = 0; j < 2; ++j) { const v4u w = xv[r][j]; float* o = X + (size_t)(m + r) * D + 512 * j + 8 * lane;
                        *(GAS f32x4*)(o) = (f32x4){__uint_as_float(w.x << 16), __uint_as_float(w.x & 0xffff0000u), __uint_as_float(w.y << 16), __uint_as_float(w.y & 0xffff0000u)} * rr * gg[2 * j];
                        *(GAS f32x4*)(o + 4) = (f32x4){__uint_as_float(w.z << 16), __uint_as_float(w.z & 0xffff0000u), __uint_as_float(w.w << 16), __uint_as_float(w.w & 0xffff0000u)} * rr * gg[2 * j + 1]; } } }
        }
        if (!prog[ph].nosync) xcd_barrier(bar);
    }
}

extern "C" void kernel_launch(void* const* d_in, const int* in_sizes, int n_in, void* d_out, int out_size, void* d_ws, size_t ws_size, hipStream_t stream) {
    static int grid = 0;
    if (grid == 0) {
        if (n_in != 17 || in_sizes[0] != M * D || out_size != M * D || ws_size < WS_NEED) { fprintf(stderr, "kernel_launch: unexpected shapes (n_in %d, out %d, ws %zu); nothing launched\n", n_in, out_size, ws_size); grid = -1; return; }
        int dev = 0, cus = 0, per_cu = 0;
        if (hipGetDevice(&dev) != hipSuccess || hipDeviceGetAttribute(&cus, hipDeviceAttributeMultiprocessorCount, dev) != hipSuccess) { grid = -1; return; }
        if (hipFuncSetAttribute((const void*)fwd, hipFuncAttributeMaxDynamicSharedMemorySize, LDS_BYTES) != hipSuccess) { fprintf(stderr, "kernel_launch: hipFuncSetAttribute failed\n"); grid = -1; return; }
        if (hipOccupancyMaxActiveBlocksPerMultiprocessor(&per_cu, (const void*)fwd, NWAVES * 64, LDS_BYTES) != hipSuccess || per_cu < 1) { fprintf(stderr, "kernel_launch: occupancy query says %d\n", per_cu); per_cu = 1; }
        (void)hipGetLastError();
        grid = cus;
    }
    if (grid < 0) return;
    (void)hipMemsetAsync((char*)d_ws + O_CTL, 0, CTL_ZERO_BYTES, stream);
    Args a{};
    for (int i = 0; i < 17; ++i) a.in[i] = (const float*)d_in[i];
    a.out = (float*)d_out; a.ws = (unsigned char*)d_ws;
    void* kargs[] = {&a};
    const hipError_t le = hipLaunchCooperativeKernel((const void*)fwd, dim3(grid), dim3(NWAVES * 64), kargs, LDS_BYTES, stream);
    if (le != hipSuccess) fprintf(stderr, "kernel_launch: cooperative launch failed: %s (grid %d)\n", hipGetErrorName(le), grid);
}
```

```cpp
#include <hip/hip_runtime.h>
#include <hip/hip_cooperative_groups.h>
#include <cstdio>
#include <cstdint>
namespace cg = cooperative_groups;
namespace pg8 {
#define PG8_LAS __attribute__((address_space(3)))
typedef unsigned short bf16_t;
typedef short bf16x8 __attribute__((ext_vector_type(8)));
typedef float f32x4 __attribute__((ext_vector_type(4)));
typedef unsigned u32x4 __attribute__((ext_vector_type(4)));
constexpr int BM = 256, BK = 64, HALF = 128, HTB = HALF * BK * 2  , STAGE_BYTES = 8 * HTB, NXCD = 8, WGM = 8;

__host__ __device__ __forceinline__ int lds_byte(int r, int c) { const int st = (r >> 4) * 2 + (c >> 5), rr = r & 15, cc = c & 31, ob = rr * 64 + cc * 2; return st * 1024 + (ob ^ (((ob >> 9) & 1) << 5)); }
__host__ __device__ __forceinline__ void stage_rc(int b, int& R, int& C) { const int st = b / 1024, sb = b % 1024, swz = sb ^ (((sb >> 9) & 1) << 5); R = (st >> 1) * 16 + swz / 64; C = (st & 1) * 32 + (swz % 64) / 2; }
__host__ __device__ __forceinline__ int perm32(int rho) { const int n = rho >> 4, i = rho & 15; return 8 * (i >> 2) + 4 * n + (i & 3); }

struct Unit { int pm, pn; };
struct Gemm { const bf16_t* A; const bf16_t* Bt; int M, N, K; };

struct StaticOrder {
    int nM, nN, nwg, G, c;
    __host__ __device__ void init(int M, int N, int G_, int c_) { nM = M / BM; nN = N / BM; nwg = nM * nN; G = G_; c = c_; }
    __host__ __device__ bool next(int i, Unit& u) const {
        const long L = (long)i * G + c; if (L >= nwg) return false;
        int wgid = (int)L; { const int q = nwg / NXCD, r = nwg % NXCD, xcd = wgid % NXCD, off = wgid / NXCD; wgid = (xcd < r ? xcd * (q + 1) : r * (q + 1) + (xcd - r) * q) + off; }
        const int nig = WGM * nN, gid = wgid / nig, fm = gid * WGM, gsz = (nM - fm) < WGM ? (nM - fm) : WGM;
        u.pm = fm + ((wgid % nig) % gsz); u.pn = (wgid % nig) / gsz; return true;
    }
    __device__ __forceinline__ void a_ready(const Unit&) const {}
    __device__ __forceinline__ void done(const Unit&) const {}
};

__device__ __forceinline__ unsigned cvt_pk_bf16(float lo, float hi) { unsigned r; asm volatile("v_cvt_pk_bf16_f32 %0, %1, %2" : "=v"(r) : "v"(lo), "v"(hi)); return r; }
typedef float f32x2 __attribute__((ext_vector_type(2)));
typedef unsigned long long rs_t;
__device__ __forceinline__ void rs_add(rs_t* p, float v) { __hip_atomic_fetch_add(p, (rs_t)(v * 16777216.f), __ATOMIC_RELAXED, __HIP_MEMORY_SCOPE_AGENT); }
__device__ __forceinline__ float rs_get(const rs_t* p) { return (float)(*p) * (1.f / 16777216.f); }
template <int ACT  > struct EpiBf16 {
    static constexpr bool PERM = true, AFTER_DRAIN = false;
    bf16_t* O; int ldc; int split_cols; size_t split_stride; float scale0, scale; const rs_t* rs; float rs_inv_n;
    __device__ __forceinline__ void operator()(const f32x4 (&acc)[2][2][4][2], const Unit& u, int wr, int wc, int fr, int fq) const {
        const int row0 = u.pm * BM + wr * 64 + fr; int colt = u.pn * BM; bf16_t* base = O;
        float sc = scale; if (split_cols) { const int t = colt / split_cols; base += (size_t)t * split_stride; colt -= t * split_cols; if (t == 0) sc *= scale0; }
        const int col0 = colt + wc * 32 + 8 * fq;
        float scv[2][4];
        if (rs) { rs_t rv[2][4];
#pragma unroll
            for (int ai = 0; ai < 2; ++ai)
#pragma unroll
                for (int m = 0; m < 4; ++m) rv[ai][m] = rs[row0 + ai * HALF + m * 16];
#pragma unroll
            for (int ai = 0; ai < 2; ++ai)
#pragma unroll
                for (int m = 0; m < 4; ++m) scv[ai][m] = sc * __builtin_amdgcn_rsqf((float)rv[ai][m] * (1.f / 16777216.f) * rs_inv_n + 1e-6f); }
        else {
#pragma unroll
            for (int ai = 0; ai < 2; ++ai)
#pragma unroll
                for (int m = 0; m < 4; ++m) scv[ai][m] = sc; }
#pragma unroll
        for (int ai = 0; ai < 2; ++ai)
#pragma unroll
            for (int m = 0; m < 4; ++m) { bf16_t* rowp = base + (size_t)(row0 + ai * HALF + m * 16) * ldc + col0;
                const float scr = scv[ai][m];
#pragma unroll
                for (int bj = 0; bj < 2; ++bj) { f32x4 v0 = acc[ai][bj][m][0], v1 = acc[ai][bj][m][1];
                    v0 = v0 * scr; v1 = v1 * scr;
                    if (ACT == 2) {
#pragma unroll
                        for (int e = 0; e < 4; ++e) { const float a = __builtin_fmaxf(v0[e], 0.f), b = __builtin_fmaxf(v1[e], 0.f); v0[e] = a * a; v1[e] = b * b; } }
                    u32x4 w; w.x = cvt_pk_bf16(v0[0], v0[1]); w.y = cvt_pk_bf16(v0[2], v0[3]); w.z = cvt_pk_bf16(v1[0], v1[1]); w.w = cvt_pk_bf16(v1[2], v1[3]);
                    *(u32x4*)(rowp + bj * HALF) = w; } }
    }
};
template <bool RES> struct EpiF32 {
    static constexpr bool PERM = true, AFTER_DRAIN = false;
    const float* base; float* out; int ldc; bf16_t* xn; rs_t* rs; const bf16_t* base16;
    __device__ __forceinline__ void emit(f32x4 o0, f32x4 o1, size_t off, float& ss) const {
        if (out) { *(f32x4*)(out + off) = o0; *(f32x4*)(out + off + 4) = o1; }
        if (RES && xn) { u32x4 w; w.x = cvt_pk_bf16(o0[0], o0[1]); w.y = cvt_pk_bf16(o0[2], o0[3]); w.z = cvt_pk_bf16(o1[0], o1[1]); w.w = cvt_pk_bf16(o1[2], o1[3]);
            *(u32x4*)(xn + off) = w;
            ss += ((o0[0] * o0[0] + o0[1] * o0[1]) + (o0[2] * o0[2] + o0[3] * o0[3])) + ((o1[0] * o1[0] + o1[1] * o1[1]) + (o1[2] * o1[2] + o1[3] * o1[3])); }
    }
    __device__ __forceinline__ void operator()(const f32x4 (&acc)[2][2][4][2], const Unit& u, int wr, int wc, int fr, int fq) const {
        const int col0 = u.pn * BM + wc * 32 + 8 * fq;
        if (RES && base16) {
#pragma unroll
            for (int ai = 0; ai < 2; ++ai) {
                u32x4 bw[4][2];
#pragma unroll
                for (int m = 0; m < 4; ++m)
#pragma unroll
                    for (int bj = 0; bj < 2; ++bj) bw[m][bj] = *(const u32x4*)(base16 + (size_t)(u.pm * BM + ai * HALF + wr * 64 + m * 16 + fr) * ldc + col0 + bj * HALF);
                asm volatile("s_waitcnt vmcnt(0)" : "+v"(bw[0][0]), "+v"(bw[0][1]), "+v"(bw[1][0]), "+v"(bw[1][1]), "+v"(bw[2][0]), "+v"(bw[2][1]), "+v"(bw[3][0]), "+v"(bw[3][1]) :: "memory");
#pragma unroll
                for (int m = 0; m < 4; ++m) { const int row = u.pm * BM + ai * HALF + wr * 64 + m * 16 + fr; const size_t off = (size_t)row * ldc + col0; float ss = 0.f;
#pragma unroll
                    for (int bj = 0; bj < 2; ++bj) { const u32x4 w = bw[m][bj];
                        const f32x4 o0 = acc[ai][bj][m][0] + (f32x4){__uint_as_float(w.x << 16), __uint_as_float(w.x & 0xffff0000u), __uint_as_float(w.y << 16), __uint_as_float(w.y & 0xffff0000u)};
                        const f32x4 o1 = acc[ai][bj][m][1] + (f32x4){__uint_as_float(w.z << 16), __uint_as_float(w.z & 0xffff0000u), __uint_as_float(w.w << 16), __uint_as_float(w.w & 0xffff0000u)};
                        emit(o0, o1, off + bj * HALF, ss); }
                    if (xn && rs) { ss += __shfl_xor(ss, 16); ss += __shfl_xor(ss, 32); if (fq == 0) rs_add(rs + row, ss); } } }
            return;
        }
#pragma unroll
        for (int ai = 0; ai < 2; ++ai)
#pragma unroll
            for (int m = 0; m < 4; ++m) { const int row = u.pm * BM + ai * HALF + wr * 64 + m * 16 + fr; const size_t off = (size_t)row * ldc + col0;
                float rsc = 1.f; if (!RES && rs) rsc = __builtin_amdgcn_rsqf(rs_get(rs + row) * (1.f / 1024.f) + 1e-6f);
                float ss = 0.f;
#pragma unroll
                for (int bj = 0; bj < 2; ++bj) { f32x4 o0 = acc[ai][bj][m][0], o1 = acc[ai][bj][m][1];
                    if (RES) { o0 = o0 + *(const f32x4*)(base + off + bj * HALF); o1 = o1 + *(const f32x4*)(base + off + bj * HALF + 4); }
                    else { o0 = o0 * rsc; o1 = o1 * rsc; }
                    emit(o0, o1, off + bj * HALF, ss); }
                if (RES && xn && rs) { ss += __shfl_xor(ss, 16); ss += __shfl_xor(ss, 32); if (fq == 0) rs_add(rs + row, ss); }
                asm volatile("" ::: "memory"); }
    }
};
struct EpiLat {
    static constexpr bool PERM = false, AFTER_DRAIN = false;
    const rs_t* rs_x; int qoff; bf16_t* ckv; bf16_t* kr; bf16_t* cq; rs_t* rsk; rs_t* rsq; const float* cs;
    __device__ __forceinline__ void operator()(const f32x4 (&acc)[2][2][4][2], const Unit& u, int wr, int wc, int fr, int fq) const {
        typedef unsigned u32x2v __attribute__((ext_vector_type(2)));
        const int colw = u.pn * BM + wc * 32;
        float rsv[2][4];
#pragma unroll
        for (int ai = 0; ai < 2; ++ai)
#pragma unroll
            for (int m = 0; m < 4; ++m) rsv[ai][m] = rs_get(rs_x + u.pm * BM + ai * HALF + wr * 64 + m * 16 + fr);
        if (qoff && colw == 256) {
#pragma unroll
            for (int ai = 0; ai < 2; ++ai)
#pragma unroll
                for (int m = 0; m < 4; ++m) { const int row = u.pm * BM + ai * HALF + wr * 64 + m * 16 + fr;
                    const float rsc = __builtin_amdgcn_rsqf(rsv[ai][m] * (1.f / 1024.f) + 1e-6f);
                    const f32x4 v0 = acc[ai][0][m][0] * rsc, v1 = acc[ai][0][m][1] * rsc;
                    const f32x4 c = *(const f32x4*)(cs + (size_t)row * 32 + 4 * fq), sn = *(const f32x4*)(cs + (size_t)row * 32 + 16 + 4 * fq);
                    const f32x4 a = v0 * c - v1 * sn, b = v1 * c + v0 * sn; u32x2v w;
                    w.x = cvt_pk_bf16(a[0], a[1]); w.y = cvt_pk_bf16(a[2], a[3]); *(u32x2v*)(kr + (size_t)row * 32 + 4 * fq) = w;
                    w.x = cvt_pk_bf16(b[0], b[1]); w.y = cvt_pk_bf16(b[2], b[3]); *(u32x2v*)(kr + (size_t)row * 32 + 16 + 4 * fq) = w; } }
#pragma unroll
        for (int ai = 0; ai < 2; ++ai)
#pragma unroll
            for (int m = 0; m < 4; ++m) { const int row = u.pm * BM + ai * HALF + wr * 64 + m * 16 + fr;
                const float rsc = __builtin_amdgcn_rsqf(rsv[ai][m] * (1.f / 1024.f) + 1e-6f);
                float sk = 0.f, sq = 0.f;
#pragma unroll
                for (int bj = 0; bj < 2; ++bj) { const int c32 = colw + bj * HALF;
                    const f32x4 v0 = acc[ai][bj][m][0] * rsc, v1 = acc[ai][bj][m][1] * rsc;
                    if (qoff && c32 < 256) {
                        u32x2v w; w.x = cvt_pk_bf16(v0[0], v0[1]); w.y = cvt_pk_bf16(v0[2], v0[3]); *(u32x2v*)(ckv + (size_t)row * 256 + c32 + 4 * fq) = w;
                        w.x = cvt_pk_bf16(v1[0], v1[1]); w.y = cvt_pk_bf16(v1[2], v1[3]); *(u32x2v*)(ckv + (size_t)row * 256 + c32 + 16 + 4 * fq) = w;
                        sk += (v0[0] * v0[0] + v0[1] * v0[1]) + (v0[2] * v0[2] + v0[3] * v0[3]) + (v1[0] * v1[0] + v1[1] * v1[1]) + (v1[2] * v1[2] + v1[3] * v1[3]);
                    } else if (qoff && c32 == 256) {
                    } else if (c32 >= qoff && c32 < qoff + 384) {
                        u32x2v w; w.x = cvt_pk_bf16(v0[0], v0[1]); w.y = cvt_pk_bf16(v0[2], v0[3]); *(u32x2v*)(cq + (size_t)row * 384 + (c32 - qoff) + 4 * fq) = w;
                        w.x = cvt_pk_bf16(v1[0], v1[1]); w.y = cvt_pk_bf16(v1[2], v1[3]); *(u32x2v*)(cq + (size_t)row * 384 + (c32 - qoff) + 16 + 4 * fq) = w;
                        sq += (v0[0] * v0[0] + v0[1] * v0[1]) + (v0[2] * v0[2] + v0[3] * v0[3]) + (v1[0] * v1[0] + v1[1] * v1[1]) + (v1[2] * v1[2] + v1[3] * v1[3]);
                    } }
                sk += __shfl_xor(sk, 16); sk += __shfl_xor(sk, 32); sq += __shfl_xor(sq, 16); sq += __shfl_xor(sq, 32);
                if (fq == 0) { if (qoff && colw < 256) rs_add(rsk + row, sk);
                               if (colw + HALF + 32 > qoff && colw < qoff + 384) rs_add(rsq + row, sq); }
                asm volatile("" ::: "memory"); }
    }
};
template <class Epi, class Sched, bool ALIGN_EPI = false, bool SP2 = false>
__device__ __forceinline__ void gemm_phase(PG8_LAS unsigned char* lds, const Gemm g, const Sched& S, const Epi& E) {
    int tid_ = threadIdx.x; asm volatile("" : "+v"(tid_));
    const int tid = tid_, wid = __builtin_amdgcn_readfirstlane(tid >> 6), lane = tid & 63, wr = wid >> 2, wc = wid & 3, fr = lane & 15, fq = lane >> 4;
    const int K = g.K, nt = K / BK;
    unsigned voffA[2], voffB[2];
#pragma unroll
    for (int i = 0; i < 2; ++i) { int R, C; stage_rc(tid * 16 + i * 8192, R, C); const int Rb = Epi::PERM ? ((R & ~31) + perm32(R & 31)) : R;
        voffA[i] = (unsigned)(R * K + C) * 2u; voffB[i] = (unsigned)(Rb * K + C) * 2u; }
    const size_t kstep = (size_t)(BK * 2);
    const size_t hstep = (size_t)HALF * K * 2;
    const size_t tstep = 2 * hstep;
    const unsigned ldsw = (unsigned)wid * 1024u;
    const int aoff = lds_byte(wr * 64 + fr, fq * 8), boff = lds_byte(wc * 32 + fr, fq * 8);
#define PG8_SA(b, h) (((b) * 2 + (h)) * HTB)
#define PG8_SB(b, h) ((4 + (b) * 2 + (h)) * HTB)
#define PG8_STAGE(bufoff, gbase, voff) do { _Pragma("unroll") for (int _i = 0; _i < 2; ++_i) \
        __builtin_amdgcn_global_load_lds((const unsigned*)((const char*)(gbase) + (voff)[_i]), (PG8_LAS unsigned*)(lds + (bufoff) + ldsw + _i * 8192), 16, 0, 0); } while (0)
#define PG8_LDA(dst, b, h) do { _Pragma("unroll") for (int m = 0; m < 4; ++m) _Pragma("unroll") for (int k = 0; k < 2; ++k) dst[m][k] = *(const PG8_LAS bf16x8*)(lds + PG8_SA(b, h) + aoff + m * 2048 + k * 1024); } while (0)
#define PG8_LDB(dst, b, h) do { _Pragma("unroll") for (int n = 0; n < 2; ++n) _Pragma("unroll") for (int k = 0; k < 2; ++k) dst[n][k] = *(const PG8_LAS bf16x8*)(lds + PG8_SB(b, h) + boff + n * 2048 + k * 1024); } while (0)
#define PG8_MMA(ai, bj, At, Bt) do { __builtin_amdgcn_s_setprio(1); _Pragma("unroll") for (int m = 0; m < 4; ++m) _Pragma("unroll") for (int n = 0; n < 2; ++n) _Pragma("unroll") for (int k = 0; k < 2; ++k) \
        acc[ai][bj][m][n] = __builtin_amdgcn_mfma_f32_16x16x32_bf16(Bt[n][k], At[m][k], acc[ai][bj][m][n], 0, 0, 0); __builtin_amdgcn_s_setprio(0); } while (0)
#define PG8_WAIT_V(n) asm volatile("s_waitcnt vmcnt(" #n ")" ::: "memory")
#define PG8_WAIT_L(n) asm volatile("s_waitcnt lgkmcnt(" #n ")" ::: "memory")
#define PG8_BAR __builtin_amdgcn_s_barrier()
#define PG8_SCHED __builtin_amdgcn_sched_barrier(0)
    Unit cur, nxt; int ui = 0;
    if (!S.next(0, cur)) return;
    f32x4 acc[2][2][4][2];
#pragma unroll
    for (int a = 0; a < 2; ++a)
#pragma unroll
        for (int b = 0; b < 2; ++b)
#pragma unroll
            for (int m = 0; m < 4; ++m)
#pragma unroll
                for (int n = 0; n < 2; ++n) acc[a][b][m][n] = (f32x4){0.f, 0.f, 0.f, 0.f};
    bf16x8 At[4][2], B0[2][2], B1[2][2];
    const char* cA = (const char*)g.A + (size_t)cur.pm * tstep; const char* cB = (const char*)g.Bt + (size_t)cur.pn * tstep;
    S.a_ready(cur);
    if constexpr (SP2) {
        PG8_STAGE(PG8_SB(0, 0), cB, voffB); PG8_STAGE(PG8_SB(0, 1), cB + hstep, voffB); PG8_STAGE(PG8_SA(0, 0), cA, voffA); PG8_STAGE(PG8_SA(0, 1), cA + hstep, voffA);
        if (wr == 1) PG8_BAR;
        PG8_WAIT_V(2); PG8_BAR;
        PG8_STAGE(PG8_SB(1, 0), cB + kstep, voffB); PG8_STAGE(PG8_SA(1, 0), cA + kstep, voffA); PG8_STAGE(PG8_SB(1, 1), cB + hstep + kstep, voffB);
        PG8_WAIT_V(6); PG8_BAR;
    } else {
        PG8_STAGE(PG8_SB(0, 0), cB, voffB); PG8_STAGE(PG8_SA(0, 0), cA, voffA); PG8_STAGE(PG8_SB(0, 1), cB + hstep, voffB); PG8_STAGE(PG8_SA(0, 1), cA + hstep, voffA);
        if (wr == 1) PG8_BAR;
        PG8_WAIT_V(4); PG8_BAR;
        PG8_STAGE(PG8_SB(1, 0), cB + kstep, voffB); PG8_STAGE(PG8_SA(1, 0), cA + kstep, voffA); PG8_STAGE(PG8_SB(1, 1), cB + hstep + kstep, voffB);
        PG8_WAIT_V(6); PG8_BAR;
    }
    for (;;) {
        const bool has_next = S.next(ui + 1, nxt);
        const char* nA = has_next ? (const char*)g.A + (size_t)nxt.pm * tstep : cA; const char* nB = has_next ? (const char*)g.Bt + (size_t)nxt.pn * tstep : cB;
        for (int t = 0; t < nt; t += 2) {
            const bool last = (t == nt - 2);
            const char* a1 = cA + (size_t)(t + 1) * kstep;
            const char* a2 = last ? nA : cA + (size_t)(t + 2) * kstep; const char* b2 = last ? nB : cB + (size_t)(t + 2) * kstep;
            const char* a3 = a2 + kstep; const char* b3 = b2 + kstep;
            if (last && has_next) S.a_ready(nxt);
            if constexpr (SP2) {
            PG8_LDB(B0, 0, 0); PG8_LDB(B1, 0, 1); PG8_SCHED; PG8_LDA(At, 0, 0); PG8_STAGE(PG8_SA(1, 1), a1 + hstep, voffA);
            PG8_WAIT_V(8); PG8_WAIT_L(0); PG8_BAR; PG8_MMA(0, 0, At, B0); PG8_MMA(0, 1, At, B1); PG8_BAR; PG8_SCHED;
            PG8_LDA(At, 0, 1); PG8_STAGE(PG8_SB(0, 0), b2, voffB); PG8_STAGE(PG8_SB(0, 1), b2 + hstep, voffB); PG8_STAGE(PG8_SA(0, 0), a2, voffA);
            PG8_WAIT_V(8); PG8_WAIT_L(0); PG8_BAR; PG8_MMA(1, 0, At, B0); PG8_MMA(1, 1, At, B1); PG8_BAR; PG8_SCHED;
            PG8_LDB(B0, 1, 0); PG8_LDB(B1, 1, 1); PG8_SCHED; PG8_LDA(At, 1, 0); PG8_STAGE(PG8_SA(0, 1), a2 + hstep, voffA);
            PG8_WAIT_V(8); PG8_WAIT_L(0); PG8_BAR; PG8_MMA(0, 0, At, B0); PG8_MMA(0, 1, At, B1); PG8_BAR; PG8_SCHED;
            PG8_LDA(At, 1, 1); PG8_STAGE(PG8_SB(1, 0), b3, voffB); PG8_STAGE(PG8_SB(1, 1), b3 + hstep, voffB); PG8_STAGE(PG8_SA(1, 0), a3, voffA);
            PG8_WAIT_V(8); PG8_WAIT_L(0); PG8_BAR; PG8_MMA(1, 0, At, B0); PG8_MMA(1, 1, At, B1); PG8_BAR; PG8_SCHED;
            } else {
            PG8_LDB(B0, 0, 0); PG8_SCHED; PG8_LDA(At, 0, 0); PG8_STAGE(PG8_SA(1, 1), a1 + hstep, voffA);
            PG8_WAIT_L(8); PG8_BAR; PG8_WAIT_L(0); PG8_MMA(0, 0, At, B0); PG8_BAR; PG8_SCHED;
            PG8_LDB(B1, 0, 1); PG8_STAGE(PG8_SB(0, 0), b2, voffB);
            PG8_BAR; PG8_WAIT_L(0); PG8_MMA(0, 1, At, B1); PG8_BAR;
            PG8_LDA(At, 0, 1); PG8_STAGE(PG8_SA(0, 0), a2, voffA);
            PG8_BAR; PG8_WAIT_L(0); PG8_MMA(1, 0, At, B0); PG8_BAR; PG8_SCHED;
            PG8_STAGE(PG8_SB(0, 1), b2 + hstep, voffB);
            PG8_WAIT_V(6); PG8_BAR; PG8_MMA(1, 1, At, B1); PG8_BAR;
            PG8_LDB(B0, 1, 0); PG8_SCHED; PG8_LDA(At, 1, 0); PG8_STAGE(PG8_SA(0, 1), a2 + hstep, voffA);
            PG8_WAIT_L(8); PG8_BAR; PG8_WAIT_L(0); PG8_MMA(0, 0, At, B0); PG8_BAR; PG8_SCHED;
            PG8_LDB(B1, 1, 1); PG8_STAGE(PG8_SB(1, 0), b3, voffB);
            PG8_BAR; PG8_WAIT_L(0); PG8_MMA(0, 1, At, B1); PG8_BAR;
            PG8_LDA(At, 1, 1); PG8_STAGE(PG8_SA(1, 0), a3, voffA);
            PG8_BAR; PG8_WAIT_L(0); PG8_MMA(1, 0, At, B0); PG8_BAR; PG8_SCHED;
            PG8_STAGE(PG8_SB(1, 1), b3 + hstep, voffB);
            PG8_WAIT_V(6); PG8_BAR; PG8_MMA(1, 1, At, B1); PG8_BAR;
            }
        }
        if constexpr (ALIGN_EPI) { if (wr == 0) PG8_BAR; }
        if constexpr (!Epi::AFTER_DRAIN) { E(acc, cur, wr, wc, fr, fq); S.done(cur); }
        if (!has_next) break;
#pragma unroll
        for (int a = 0; a < 2; ++a)
#pragma unroll
            for (int b = 0; b < 2; ++b)
#pragma unroll
                for (int m = 0; m < 4; ++m)
#pragma unroll
                    for (int n = 0; n < 2; ++n) acc[a][b][m][n] = (f32x4){0.f, 0.f, 0.f, 0.f};
        cur = nxt; cA = nA; cB = nB; ++ui;
        if constexpr (ALIGN_EPI) { if (wr == 1) PG8_BAR; }
    }
    PG8_WAIT_V(0);
    if constexpr (!ALIGN_EPI) { if (wr == 0) PG8_BAR; }
    PG8_BAR;
    if constexpr (Epi::AFTER_DRAIN) { E.fused(acc, cur, wr, wc, fr, fq, lds, wid, lane); S.done(cur); }
#undef PG8_SA
#undef PG8_SB
#undef PG8_STAGE
#undef PG8_LDA
#undef PG8_LDB
#undef PG8_MMA
#undef PG8_WAIT_V
#undef PG8_WAIT_L
#undef PG8_BAR
#undef PG8_SCHED
}
}
namespace att {
#define ALAS __attribute__((address_space(3)))
typedef unsigned short bf16_t;
typedef short bf16x8 __attribute__((ext_vector_type(8)));
typedef short s16x4 __attribute__((ext_vector_type(4)));
typedef float f32x16 __attribute__((ext_vector_type(16)));
typedef float f32x4 __attribute__((ext_vector_type(4)));
typedef unsigned u32x4 __attribute__((ext_vector_type(4)));
typedef float f32x2_t __attribute__((ext_vector_type(2))); typedef __bf16 bf16x2_t __attribute__((ext_vector_type(2)));
constexpr int SEQ = 8192;
typedef ALAS char* ALAS_char_t;
__device__ __forceinline__ int crow(int r, int hi) { return (r & 3) + 8 * (r >> 2) + 4 * hi; }
#define SBAR() __builtin_amdgcn_sched_barrier(0)
__device__ __forceinline__ void glds16(const void* gsrc, unsigned lds_dst) { unsigned keep;
  asm volatile("s_mov_b32 %0, m0\n\ts_mov_b32 m0, %2\n\ts_nop 0\n\tglobal_load_lds_dwordx4 %1, off\n\ts_mov_b32 m0, %0" : "=&s"(keep) : "v"(gsrc), "s"(lds_dst) : "memory"); }
__device__ __forceinline__ unsigned cvtpk_s(float lo, float hi) { f32x2_t v = {lo, hi}; bf16x2_t b = __builtin_convertvector(v, bf16x2_t); return __builtin_bit_cast(unsigned, b); }
__device__ __forceinline__ float bf2f(short v) { return __uint_as_float(((unsigned)(unsigned short)v) << 16); }
__device__ __forceinline__ unsigned short f2bf(float f) { unsigned u = __builtin_bit_cast(unsigned, f); return (unsigned short)((u + 0x7fffu + ((u >> 16) & 1u)) >> 16); }
#define MFMA32(a, b, c) __builtin_amdgcn_mfma_f32_32x32x16_bf16((a), (b), (c), 0, 0, 0)
template <int NK> __device__ __forceinline__ void qkt(f32x16& p0, f32x16& p1, const ALAS char* kb, const bf16x8* qr, const f32x16& cinit) {
#pragma unroll
  for (int d0 = 0; d0 < NK; ++d0) {
    const bf16x8 b0 = *(const ALAS bf16x8*)(kb + d0 * 2048);
    const bf16x8 b1 = *(const ALAS bf16x8*)(kb + d0 * 2048 + 512);
    if (d0 == 0) { p0 = MFMA32(b0, qr[0], cinit); p1 = MFMA32(b1, qr[0], cinit); }
    else { p0 = MFMA32(b0, qr[d0], p0); p1 = MFMA32(b1, qr[d0], p1); } }
}
__device__ __forceinline__ void pv(f32x16* o, int vb, bf16x8 pa0, bf16x8 pa1, bf16x8 pa2, bf16x8 pa3) {
#pragma unroll
  for (int d0 = 0; d0 < 2; ++d0) { s16x4 lo[4], hi[4];
#pragma unroll
    for (int ks = 0; ks < 4; ++ks) {
      asm volatile("ds_read_b64_tr_b16 %0,%1 offset:%c2" : "=&v"(lo[ks]) : "v"(vb), "i"(d0 * 4096 + ks * 1024) : "memory");
      asm volatile("ds_read_b64_tr_b16 %0,%1 offset:%c2" : "=&v"(hi[ks]) : "v"(vb), "i"(d0 * 4096 + ks * 1024 + 512) : "memory"); }
    asm volatile("s_waitcnt lgkmcnt(0)" ::: "memory"); SBAR();
#define PK(k) (bf16x8){lo[k][0], lo[k][1], lo[k][2], lo[k][3], hi[k][0], hi[k][1], hi[k][2], hi[k][3]}
    o[d0] = MFMA32(pa0, PK(0), o[d0]); o[d0] = MFMA32(pa1, PK(1), o[d0]); o[d0] = MFMA32(pa2, PK(2), o[d0]); o[d0] = MFMA32(pa3, PK(3), o[d0]);
#undef PK
  }
}
__device__ __forceinline__ void pv2(f32x16* o, int vA, int vB, bf16x8 pa0, bf16x8 pa1, bf16x8 pa2, bf16x8 pa3) {
#pragma unroll
  for (int d0 = 0; d0 < 2; ++d0) { s16x4 lo[4], hi[4]; const int vb = d0 ? vB : vA;
#pragma unroll
    for (int ks = 0; ks < 4; ++ks) {
      asm volatile("ds_read_b64_tr_b16 %0,%1 offset:%c2" : "=&v"(lo[ks]) : "v"(vb), "i"(ks * 2048) : "memory");
      asm volatile("ds_read_b64_tr_b16 %0,%1 offset:%c2" : "=&v"(hi[ks]) : "v"(vb), "i"(ks * 2048 + 1024) : "memory"); }
    asm volatile("s_waitcnt lgkmcnt(0)" ::: "memory"); SBAR();
#define PK(k) (bf16x8){lo[k][0], lo[k][1], lo[k][2], lo[k][3], hi[k][0], hi[k][1], hi[k][2], hi[k][3]}
    o[d0] = MFMA32(pa0, PK(0), o[d0]); o[d0] = MFMA32(pa1, PK(1), o[d0]); o[d0] = MFMA32(pa2, PK(2), o[d0]); o[d0] = MFMA32(pa3, PK(3), o[d0]);
#undef PK
  }
}
__device__ __forceinline__ float rowmax(const f32x16& p0, const f32x16& p1) {
  float a = __builtin_fmaxf(p0[0], p1[0]), b = __builtin_fmaxf(p0[1], p1[1]);
#pragma unroll
  for (int r = 2; r < 16; r += 2) { a = __builtin_fmaxf(a, __builtin_fmaxf(p0[r], p1[r])); b = __builtin_fmaxf(b, __builtin_fmaxf(p0[r + 1], p1[r + 1])); }
  const float m = __builtin_fmaxf(a, b);
  auto rr = __builtin_amdgcn_permlane32_swap(__float_as_uint(m), __float_as_uint(m), false, false);
  return __builtin_fmaxf(__uint_as_float(rr[0]), __uint_as_float(rr[1]));
}
__device__ __forceinline__ float max3a(float a, float b, float c) { float r; asm("v_max3_f32 %0, %1, %2, %3" : "=v"(r) : "v"(a), "v"(b), "v"(c)); return r; }
__device__ __forceinline__ float max16a(const f32x16& p) { float a, b;
  asm("v_max3_f32 %0, %2, %3, %4\n\tv_max3_f32 %1, %5, %6, %7\n\tv_max3_f32 %0, %0, %8, %9\n\tv_max3_f32 %1, %1, %10, %11\n\tv_max3_f32 %0, %0, %12, %13\n\tv_max3_f32 %1, %1, %14, %15\n\tv_max3_f32 %0, %0, %16, %17\n\tv_max_f32_e32 %0, %0, %1"
      : "=&v"(a), "=&v"(b) : "v"(p[0]), "v"(p[1]), "v"(p[2]), "v"(p[3]), "v"(p[4]), "v"(p[5]), "v"(p[6]), "v"(p[7]), "v"(p[8]), "v"(p[9]), "v"(p[10]), "v"(p[11]), "v"(p[12]), "v"(p[13]), "v"(p[14]), "v"(p[15]));
  return a; }
__device__ __forceinline__ float rowmax_a(const f32x16& p0, const f32x16& p1) {
  const float a = max16a(p0), b = max16a(p1); float m; asm("v_max_f32_e32 %0, %1, %2" : "=v"(m) : "v"(a), "v"(b));
  auto rr = __builtin_amdgcn_permlane32_swap(__float_as_uint(m), __float_as_uint(m), false, false);
  float q; { const float x = __uint_as_float(rr[0]), y = __uint_as_float(rr[1]); asm("v_max_f32_e32 %0, %1, %2" : "=v"(q) : "v"(x), "v"(y)); }
  return q;
}
#define PKW(P, B) cvtpk_s(P[B], P[B + 1])
__device__ __forceinline__ void store_o(const f32x16* o, bf16_t* Ow, int pitch, ALAS bf16_t* stg, int lane) {
  const int r32 = lane & 31, hi = lane >> 5;
#pragma unroll
  for (int r = 0; r < 16; ++r) { const int orow = crow(r, hi);
#pragma unroll
    for (int d0 = 0; d0 < 2; ++d0) stg[orow * 64 + d0 * 32 + r32] = f2bf(o[d0][r]); }
  asm volatile("s_waitcnt lgkmcnt(0)" ::: "memory");
#pragma unroll
  for (int i = 0; i < 4; ++i) { const int row = i * 8 + (lane >> 3), ch = lane & 7; const u32x4 v = *(const ALAS u32x4*)(stg + row * 64 + ch * 8); *(u32x4*)(Ow + (long)row * pitch + ch * 8) = v; }
  asm volatile("s_waitcnt lgkmcnt(0)" ::: "memory");
}

struct SbConsts { bf16x8 T0, T1, ONES; };
__device__ __forceinline__ void sb_consts(SbConsts& c, int lane) {
  const int r = lane & 31, h = lane >> 5;
#pragma unroll
  for (int j = 0; j < 8; ++j) { const int kin = 8 * (j >> 2) + 4 * h + (j & 3); c.T0[j] = (kin > r) ? (short)0xBF80 : (short)0; c.T1[j] = (16 + kin > r) ? (short)0xBF80 : (short)0; c.ONES[j] = (short)0xBF80; }
}
__device__ __forceinline__ void sb_unit(int b, int h, int qblk, const bf16_t* Q, const bf16_t* __restrict__ K, const bf16_t* __restrict__ V, bf16_t* O, ALAS char* wl, const SbConsts& tc) {
  int tid_ = threadIdx.x; asm volatile("" : "+v"(tid_));
  const int lane = tid_ & 63, r32 = lane & 31, hi = lane >> 5;
  const long rowbase = (long)b * SEQ; const int q0 = qblk * 32;
  const bf16_t* Qw = Q + (rowbase + q0) * 1024 + h * 64;
  const bf16_t* Kh = K + rowbase * 1024 + h * 64; const bf16_t* Vh = V + rowbase * 1024 + h * 64;
  const unsigned kslot = (unsigned)__builtin_amdgcn_readfirstlane((int)(unsigned)(uintptr_t)wl), vslot = kslot + 8192u;
  bf16x8 qr[4];
#pragma unroll
  for (int d0 = 0; d0 < 4; ++d0) qr[d0] = *(const bf16x8*)(Qw + (long)r32 * 1024 + d0 * 16 + hi * 8);
  f32x16 o[2]; o[0] = f32x16{}; o[1] = f32x16{}; float C = 0.f;
  const ALAS char* kp = wl + r32 * 128; const int kg = (r32 >> 1) & 7;
  const int vq = (lane & 15) >> 2;
  const int vbA = (int)vslot + (4 * hi + vq) * 128 + ((vq >> 1) & 1) * 64 + ((lane >> 4) & 1) * 32 + (lane & 3) * 8, vbB = vbA ^ 64;
  const int tdiag = q0 >> 6;
  for (int t = tdiag; t >= 0; --t) {
    { const bf16_t* ks = Kh + (long)(64 * t + (lane >> 3)) * 1024;
#pragma unroll
      for (int p = 0; p < 8; ++p) glds16(ks + (long)(8 * p) * 1024 + (((lane & 7) ^ ((4 * p + (lane >> 4)) & 7)) * 8), kslot + p * 1024);
      const bf16_t* vs = Vh + (long)(64 * t + (lane >> 3)) * 1024 + (((lane & 7) ^ (((lane >> 4) & 1) << 2)) * 8);
#pragma unroll
      for (int p = 0; p < 8; ++p) glds16(vs + (long)(8 * p) * 1024, vslot + p * 1024); }
    asm volatile("s_waitcnt vmcnt(0)" ::: "memory");
    f32x16 y0, y1;
    { const f32x16 z = f32x16{}; bf16x8 kf[8];
#pragma unroll
      for (int d0 = 0; d0 < 4; ++d0) { const int off = ((2 * d0 + hi) ^ kg) << 4; kf[2 * d0] = *(const ALAS bf16x8*)(kp + off); kf[2 * d0 + 1] = *(const ALAS bf16x8*)(kp + off + 4096); }
      SBAR();
#pragma unroll
      for (int d0 = 0; d0 < 4; ++d0) {
        if (d0 == 0) { y0 = MFMA32(kf[0], qr[0], z); y1 = MFMA32(kf[1], qr[0], z); } else { y0 = MFMA32(kf[2 * d0], qr[d0], y0); y1 = MFMA32(kf[2 * d0 + 1], qr[d0], y1); } } }
    if (t == tdiag) { const int qrel = (q0 & 63) + r32;
      asm volatile("" : "+v"(y0), "+v"(y1));
#pragma unroll
      for (int r = 0; r < 16; ++r) { const int kv = 4 * hi + (r & 3) + 8 * (r >> 2); if (kv >= qrel) y0[r] = -1e30f; if (kv + 32 >= qrel) y1[r] = -1e30f; } }
    f32x16 L0, L1;
#pragma unroll
    for (int r = 0; r < 16; ++r) { y0[r] = __builtin_amdgcn_fmed3f(y0[r], -3.0e38f, 64.f); y1[r] = __builtin_amdgcn_fmed3f(y1[r], -3.0e38f, 64.f); }
    SBAR();
#pragma unroll
    for (int r = 0; r < 16; ++r) { L0[r] = __builtin_amdgcn_exp2f(y0[r]); L1[r] = __builtin_amdgcn_exp2f(y1[r]); }
    SBAR();
#pragma unroll
    for (int r = 0; r < 16; ++r) { L0[r] = 1.f + L0[r]; L1[r] = 1.f + L1[r]; }
    SBAR();
#pragma unroll
    for (int r = 0; r < 16; ++r) { L0[r] = __builtin_amdgcn_logf(L0[r]); L1[r] = __builtin_amdgcn_logf(L1[r]); }
    SBAR();
#pragma unroll
    for (int r = 0; r < 16; ++r) { y0[r] = y0[r] - L0[r]; y1[r] = y1[r] - L1[r]; }
    SBAR();
    u32x4 w0, w1, w2, w3;
    w0 = (u32x4){PKW(L0, 0), PKW(L0, 2), PKW(L0, 4), PKW(L0, 6)}; w1 = (u32x4){PKW(L0, 8), PKW(L0, 10), PKW(L0, 12), PKW(L0, 14)};
    w2 = (u32x4){PKW(L1, 0), PKW(L1, 2), PKW(L1, 4), PKW(L1, 6)}; w3 = (u32x4){PKW(L1, 8), PKW(L1, 10), PKW(L1, 12), PKW(L1, 14)};
    f32x16 cv;
#pragma unroll
    for (int r = 0; r < 16; ++r) cv[r] = C;
    f32x16 S0 = MFMA32(tc.T0, __builtin_bit_cast(bf16x8, w0), cv); S0 = MFMA32(tc.T1, __builtin_bit_cast(bf16x8, w1), S0);
    S0 = MFMA32(tc.ONES, __builtin_bit_cast(bf16x8, w2), S0); S0 = MFMA32(tc.ONES, __builtin_bit_cast(bf16x8, w3), S0);
    f32x16 S1 = MFMA32(tc.T0, __builtin_bit_cast(bf16x8, w2), cv); S1 = MFMA32(tc.T1, __builtin_bit_cast(bf16x8, w3), S1);
#pragma unroll
    for (int r = 0; r < 16; ++r) { y0[r] = y0[r] + S0[r]; y1[r] = y1[r] + S1[r]; }
    SBAR();
#pragma unroll
    for (int r = 0; r < 16; ++r) { y0[r] = __builtin_amdgcn_exp2f(y0[r]); y1[r] = __builtin_amdgcn_exp2f(y1[r]); }
    SBAR();
    { const float tot = S0[0] - L0[0]; auto rr = __builtin_amdgcn_permlane32_swap(__float_as_uint(tot), __float_as_uint(tot), false, false); C = __uint_as_float(rr[0]); }
    w0 = (u32x4){PKW(y0, 0), PKW(y0, 2), PKW(y0, 4), PKW(y0, 6)}; w1 = (u32x4){PKW(y0, 8), PKW(y0, 10), PKW(y0, 12), PKW(y0, 14)};
    w2 = (u32x4){PKW(y1, 0), PKW(y1, 2), PKW(y1, 4), PKW(y1, 6)}; w3 = (u32x4){PKW(y1, 8), PKW(y1, 10), PKW(y1, 12), PKW(y1, 14)};
    SBAR(); pv2(o, vbA, vbB, __builtin_bit_cast(bf16x8, w0), __builtin_bit_cast(bf16x8, w1), __builtin_bit_cast(bf16x8, w2), __builtin_bit_cast(bf16x8, w3));
    if (__all(C < -151.f)) break;
  }
  store_o(o, O + (rowbase + q0) * 1024 + h * 64, 1024, (ALAS bf16_t*)wl, lane);
}

constexpr int KSLOT = 12288, VSLOT = 8192, NSLOT = 3;
constexpr int LDS_K = 0, LDS_V = NSLOT * KSLOT, LDS_WS = LDS_V + NSLOT * VSLOT, LDS_OST = LDS_WS + 8 * 64 * 4, LDS_BYTES = LDS_OST + 8 * 4096;
#define WAIT_BAR(N) asm volatile("s_waitcnt vmcnt(" #N ") lgkmcnt(0)\n\ts_barrier" ::: "memory")
template <int THRL> __device__ __forceinline__ void mla_unit(int b, int h, int qb, const bf16_t* QB, const bf16_t* __restrict__ KVB, const bf16_t* __restrict__ KR, const float* __restrict__ CS, bf16_t* O, ALAS char* shm) {
  int tid_ = threadIdx.x; asm volatile("" : "+v"(tid_));
  const int tid = tid_, lane = tid & 63, r32 = lane & 31, hi = lane >> 5; const int wid = __builtin_amdgcn_readfirstlane(tid >> 6);
  const long rowbase = (long)b * SEQ; const int q0 = qb * 256;
  const unsigned lds0 = (unsigned)(uintptr_t)shm;
  ALAS float* wsf = (ALAS float*)(shm + LDS_WS) + wid * 64;
  const int NT = (q0 + 256) / 64;
  const long qrow = rowbase + q0 + wid * 32 + r32;
  bf16x8 qr[6];
  { const bf16_t* Qw = QB + qrow * 1536 + h * 96;
#pragma unroll
    for (int d0 = 0; d0 < 6; ++d0) qr[d0] = *(const bf16x8*)(Qw + d0 * 16 + hi * 8);
    const float* cs = CS + qrow * 32 + 8 * hi;
    const f32x4 c0 = *(const f32x4*)(cs), c1 = *(const f32x4*)(cs + 4), s0 = *(const f32x4*)(cs + 16), s1 = *(const f32x4*)(cs + 20);
#pragma unroll
    for (int j = 0; j < 8; ++j) { const float c = j < 4 ? c0[j & 3] : c1[j & 3], s = j < 4 ? s0[j & 3] : s1[j & 3];
      const float t1 = bf2f(qr[4][j]), t2 = bf2f(qr[5][j]); qr[4][j] = (short)f2bf(t1 * c - t2 * s); qr[5][j] = (short)f2bf(t2 * c + t1 * s); } }
  const bf16_t* ksrc = KVB + (rowbase + 8 * wid + (lane >> 3)) * 2048 + h * 128 + (((lane & 7) ^ ((4 * wid + (lane >> 4)) & 7)) * 8);
  const bf16_t* rsrc = KR + (rowbase + 16 * (wid & 3) + (lane >> 2)) * 32 + (((lane & 3) ^ ((lane >> 4) & 3)) * 8);
  const bf16_t* vsrc = KVB + (rowbase + 8 * wid + (lane >> 3)) * 2048 + h * 128 + 64 + (((lane & 7) ^ (((lane >> 4) & 1) << 2)) * 8);
  const unsigned kdst = lds0 + LDS_K + wid * 1024, rdst = lds0 + LDS_K + 8192 + (wid & 3) * 1024, vdst = lds0 + LDS_V + wid * 1024;
  const bool ropew = wid < 4;
#define DMA(t, s) do { glds16(ksrc + (long)(t) * 64 * 2048, (unsigned)__builtin_amdgcn_readfirstlane((int)(kdst + (s) * KSLOT))); \
    if (ropew) glds16(rsrc + (long)(t) * 64 * 32, (unsigned)__builtin_amdgcn_readfirstlane((int)(rdst + (s) * KSLOT))); \
    glds16(vsrc + (long)(t) * 64 * 2048, (unsigned)__builtin_amdgcn_readfirstlane((int)(vdst + (s) * VSLOT))); } while (0)
  asm volatile("s_waitcnt vmcnt(0)" ::: "memory");
  DMA(0, 0); DMA(1, 1);
  float mhat = 0.f; f32x16 o[2]; o[0] = f32x16{}; o[1] = f32x16{}; f32x16 negm = f32x16{}; f32x16 lacc = f32x16{};
  bf16x8 ones; { _Pragma("unroll") for (int j = 0; j < 8; ++j) ones[j] = (short)0x3F80; }
  bool first = true;
  const ALAS char* kp0 = (const ALAS char*)shm + LDS_K + r32 * 128; const ALAS char* rp0 = (const ALAS char*)shm + LDS_K + 8192 + r32 * 64;
  const int kg = (r32 >> 1) & 7, rg = (r32 >> 2) & 3;
  const int vq = (lane & 15) >> 2; const int vbA0 = (int)(lds0 + LDS_V) + (4 * hi + vq) * 128 + ((vq >> 1) & 1) * 64 + ((lane >> 4) & 1) * 32 + (lane & 3) * 8;
  int slot = 0, slot2 = 2;
  for (int t = 0; t < NT; ++t) {
    if (t + 1 >= NT) WAIT_BAR(0); else if (ropew) WAIT_BAR(3); else WAIT_BAR(2);
    if (t + 2 < NT) DMA(t + 2, slot2);
    const int jb = t - (NT - 4);
    if (jb <= (wid >> 1)) {
      f32x16 c0, c1;
      { const ALAS char* kp_ = kp0 + slot * KSLOT; const ALAS char* rp_ = rp0 + slot * KSLOT;
        bf16x8 kf[12];
#pragma unroll
        for (int d0 = 0; d0 < 6; ++d0) {
          if (d0 < 4) { const int off = ((2 * d0 + hi) ^ kg) << 4; kf[2 * d0] = *(const ALAS bf16x8*)(kp_ + off); kf[2 * d0 + 1] = *(const ALAS bf16x8*)(kp_ + off + 4096); }
          else { const int off = ((2 * (d0 - 4) + hi) ^ rg) << 4; kf[2 * d0] = *(const ALAS bf16x8*)(rp_ + off); kf[2 * d0 + 1] = *(const ALAS bf16x8*)(rp_ + off + 2048); } }
        SBAR();
#pragma unroll
        for (int d0 = 0; d0 < 6; ++d0) {
          if (d0 == 0) { c0 = MFMA32(kf[0], qr[0], negm); c1 = MFMA32(kf[1], qr[0], negm); } else { c0 = MFMA32(kf[2 * d0], qr[d0], c0); c1 = MFMA32(kf[2 * d0 + 1], qr[d0], c1); } } }
      asm volatile("s_nop 15\n\ts_nop 7" : "+v"(c0), "+v"(c1));
      const float rm = rowmax_a(c0, c1);
      if (first || __any(rm > (float)THRL)) {
        const float dl = first ? rm : __builtin_fmaxf(rm, 0.f); mhat += dl;
#pragma unroll
        for (int r = 0; r < 16; ++r) { c0[r] -= dl; c1[r] -= dl; negm[r] = -mhat; }
        if (!first) { const float f = __builtin_amdgcn_exp2f(-dl); if (hi == 0) wsf[r32] = f;
          asm volatile("s_waitcnt lgkmcnt(0)" ::: "memory");
#pragma unroll
          for (int d = 0; d < 2; ++d)
#pragma unroll
            for (int r = 0; r < 16; ++r) o[d][r] *= wsf[crow(r, hi)];
#pragma unroll
          for (int r = 0; r < 16; ++r) lacc[r] *= wsf[crow(r, hi)]; }
        first = false; }
#pragma unroll
      for (int r = 0; r < 16; ++r) { c0[r] = __builtin_amdgcn_exp2f(c0[r]); c1[r] = __builtin_amdgcn_exp2f(c1[r]); }
      u32x4 w0, w1, w2, w3;
      w0 = (u32x4){PKW(c0, 0), PKW(c0, 2), PKW(c0, 4), PKW(c0, 6)}; w1 = (u32x4){PKW(c0, 8), PKW(c0, 10), PKW(c0, 12), PKW(c0, 14)};
      w2 = (u32x4){PKW(c1, 0), PKW(c1, 2), PKW(c1, 4), PKW(c1, 6)}; w3 = (u32x4){PKW(c1, 8), PKW(c1, 10), PKW(c1, 12), PKW(c1, 14)};
      SBAR(); pv2(o, vbA0 + slot * VSLOT, (vbA0 + slot * VSLOT) ^ 64, __builtin_bit_cast(bf16x8, w0), __builtin_bit_cast(bf16x8, w1), __builtin_bit_cast(bf16x8, w2), __builtin_bit_cast(bf16x8, w3));
      lacc = MFMA32(__builtin_bit_cast(bf16x8, w0), ones, lacc); lacc = MFMA32(__builtin_bit_cast(bf16x8, w1), ones, lacc); lacc = MFMA32(__builtin_bit_cast(bf16x8, w2), ones, lacc); lacc = MFMA32(__builtin_bit_cast(bf16x8, w3), ones, lacc);
    }
    slot = (slot == 2) ? 0 : slot + 1; slot2 = (slot2 == 2) ? 0 : slot2 + 1;
  }
#undef DMA
#pragma unroll
  for (int r = 0; r < 16; ++r) { const float rl = __builtin_amdgcn_rcpf(lacc[r]); o[0][r] *= rl; o[1][r] *= rl; }
  store_o(o, O + (rowbase + q0 + wid * 32) * 1024 + h * 64, 1024, (ALAS bf16_t*)(shm + LDS_OST) + wid * 2048, lane);
  asm volatile("s_waitcnt lgkmcnt(0)\n\ts_barrier" ::: "memory");
}
#undef WAIT_BAR
#undef PKW
#undef SBAR
}
#define GAS __attribute__((address_space(1)))
#define LAS __attribute__((address_space(3)))
typedef unsigned short bf16;
typedef unsigned v4u __attribute__((ext_vector_type(4)));
typedef float f32x4 __attribute__((ext_vector_type(4)));
typedef short bf16x8 __attribute__((ext_vector_type(8)));
typedef GAS unsigned gu32;
typedef GAS unsigned long long gu64;
#define RLX_AGENT __ATOMIC_RELAXED, __HIP_MEMORY_SCOPE_AGENT
#define LDS_WAIT() asm volatile("s_waitcnt lgkmcnt(0)" ::: "memory")
#define VM_WAIT() asm volatile("s_waitcnt vmcnt(0)" ::: "memory")
__device__ __forceinline__ unsigned long long rt() { return __builtin_amdgcn_s_memrealtime(); }
__device__ __forceinline__ unsigned f2bf(float f) { unsigned u = __builtin_bit_cast(unsigned, f); return (u + 0x7fffu + ((u >> 16) & 1u)) >> 16; }
__device__ __forceinline__ unsigned pk2(float lo, float hi) { return f2bf(lo) | (f2bf(hi) << 16); }

#define XB_TMO      128
#define XB_XCNT(j)  (256  + 64 * (j))
#define XB_XSUB(j)  (1280 + 64 * (j))
#define XB_XGEN(j)  (2304 + 64 * (j))
#define XB_TOP      3328
#define XB_TOPGEN   3392
#define XCD_BAR_WORDS 3456
#define XB_SPIN_CAP (1u << 18)

__device__ __forceinline__ unsigned xb_ld(unsigned* p)              { return __hip_atomic_load(p, __ATOMIC_RELAXED, __HIP_MEMORY_SCOPE_AGENT); }
__device__ __forceinline__ unsigned xb_add(unsigned* p, unsigned v) { return __hip_atomic_fetch_add(p, v, __ATOMIC_RELAXED, __HIP_MEMORY_SCOPE_AGENT); }
__device__ __forceinline__ unsigned xb_xcc_id() { return (unsigned)__builtin_amdgcn_s_getreg((3 << 11) | 20) & 0xFu; }
#define XB_SPIN(cond, bar) do { unsigned _sp = 0; while (cond) { __builtin_amdgcn_s_sleep(1); \
    if ((++_sp & 255u) == 0u) { if (xb_ld(&(bar)[XB_TMO])) break; if (_sp > XB_SPIN_CAP) { atomicAdd(&(bar)[XB_TMO], 1u); break; } } } } while (0)

struct XcdBarrier {
    unsigned* bar; unsigned x;
    volatile LAS unsigned* st;
};

__device__ __forceinline__ XcdBarrier xcd_barrier_post(unsigned* bar, volatile LAS unsigned* st) {
    XcdBarrier b; b.bar = bar; b.x = xb_xcc_id(); b.st = st;
    if (threadIdx.x == 0) (void)xb_add(&bar[XB_XCNT(b.x)], 1u);
    return b;
}
__device__ __forceinline__ void xcd_barrier_complete(unsigned* bar, unsigned x, unsigned& nloc, unsigned& nx) {
    const unsigned G = gridDim.x * gridDim.y * gridDim.z;
    unsigned sum, cnt, mine, sp = 0u;
    for (;;) {
        sum = 0u; cnt = 0u; mine = 0u;
#pragma unroll
        for (unsigned j = 0; j < 16; ++j) { const unsigned c = xb_ld(&bar[XB_XCNT(j)]); sum += c; cnt += (c > 0u) ? 1u : 0u; mine = (j == x) ? c : mine; }
        if (sum == G) break;
        __builtin_amdgcn_s_sleep(1);
        if ((++sp & 255u) == 0u) { if (xb_ld(&bar[XB_TMO])) break; if (sp > XB_SPIN_CAP) { atomicAdd(&bar[XB_TMO], 1u); break; } }
    }
    nloc = mine > 0u ? mine : 1u; nx = cnt > 0u ? cnt : 1u;
}

__device__ __forceinline__ void xcd_barrier(const XcdBarrier& b) {
    asm volatile("s_waitcnt vmcnt(0)" ::: "memory");
    __syncthreads();
    if (threadIdx.x == 0) {
        unsigned* bar = b.bar;
        __builtin_amdgcn_s_waitcnt(0);
        unsigned nloc = b.st[0], nx = b.st[1];
        if (nloc == 0u) { xcd_barrier_complete(bar, b.x, nloc, nx); b.st[0] = nloc; b.st[1] = nx; }
        const unsigned old = xb_add(&bar[XB_XSUB(b.x)], 1u);
        const unsigned gen = old / nloc;
        if (old + 1u == (gen + 1u) * nloc) {
            __builtin_amdgcn_fence(__ATOMIC_RELEASE, "agent");
            asm volatile("s_waitcnt vmcnt(0)" ::: "memory");
            const unsigned og = xb_add(&bar[XB_TOP], 1u);
            const unsigned tg = og / nx;
            if (og + 1u == (tg + 1u) * nx) xb_add(&bar[XB_TOPGEN], 1u);
            else XB_SPIN(xb_ld(&bar[XB_TOPGEN]) == tg, bar);
            __builtin_amdgcn_fence(__ATOMIC_ACQUIRE, "agent");
            xb_add(&bar[XB_XGEN(b.x)], 1u);
            asm volatile("s_waitcnt vmcnt(0)" ::: "memory");
        } else {
            XB_SPIN(xb_ld(&bar[XB_XGEN(b.x)]) == gen, bar);
            __builtin_amdgcn_fence(__ATOMIC_ACQUIRE, "agent");
            asm volatile("s_waitcnt vmcnt(0)" ::: "memory");
        }
    }
    __syncthreads();
}
constexpr int NWAVES = 8;
constexpr int SEQ = 8192, M = 2 * SEQ, D = 1024, FF = 4096;
constexpr float NORM_EPS = 1e-6f;
constexpr float LOG2E = 1.4426950408889634f;
constexpr float C2_SB = 0.125f * LOG2E;
constexpr float C2_MLA = 0.10206207261596575f * LOG2E;
constexpr unsigned MB = 1u << 20, KB = 1u << 10;
constexpr unsigned O_CTL = 0, CTL_ZERO_BYTES = 16 * KB;
constexpr unsigned O_RS = 64 * KB, N_RS = 11;
constexpr unsigned O_WQKV = 2 * MB, O_WOSB = 14 * MB, O_W1A = 18 * MB, O_W2A = 34 * MB, O_W1B = 50 * MB, O_W2B = 66 * MB, O_WD0 = 82 * MB,
                   O_WD1 = O_WD0 + 1536 * KB, O_WUKV = O_WD1 + 1 * MB,
                   O_WUQ = O_WUKV + 1 * MB, O_WOM = O_WUQ + 2304 * KB;
constexpr unsigned O_XN = 92 * MB;
constexpr unsigned O_Q = 124 * MB, O_K = 156 * MB, O_V = 188 * MB, O_OA = 220 * MB;
constexpr unsigned O_H = 124 * MB;
constexpr unsigned O_KVB = 124 * MB, O_KR = 188 * MB, O_DQ = 189 * MB, O_QB = 189 * MB, O_H2 = 189 * MB, O_CQ = 237 * MB, O_CKV = 2 * MB  , O_OB = 18 * MB  ;
constexpr unsigned O_CS = 253 * MB;
constexpr size_t WS_NEED = (size_t)255 * MB;
static_assert(O_WOM + 4 * MB <= O_XN, "weights");

enum { OP_GB = 0, OP_GR2 = 1, OP_GRES = 2, OP_GLAT = 3, OP_ATTA = 4, OP_ATTB = 5, OP_NORM = 6, OP_LAT = 7, OP_FINAL = 8 };
struct Ph { int op; unsigned a, b, c; int N, K, ldc, p0; float s0, s1; int nosync; int rs; };
#define PH_A_LAYER(l) \
  {OP_GB, O_XN, O_WQKV + (l) * 6 * MB, O_Q, 3072, 1024, 1024, 1024, C2_SB, 1.f, 0, ((l) == 0 ? 0 : 2)}, \
  {OP_ATTA, 0, 0, 0, 0, 0, 0, 0, 0.f, 0.f, 0, 0}, \
  {OP_GRES, O_OA, O_WOSB + (l) * 2 * MB, 0, 1024, 1024, 1024, 34 + ((l) == 0 ? 1 : 4), 0.f, 0.f, 0, 1 + 2 * (l)}, \
  {OP_GR2, O_XN, O_W1A + (l) * 8 * MB, O_H, 4096, 1024, 4096, 0, 1.f, 1.f, 0, 1 + 2 * (l)}, \
  {OP_GRES, O_H, O_W2A + (l) * 8 * MB, 0, 1024, 4096, 1024, 38, 0.f, 0.f, 0, 2 + 2 * (l)}
__constant__ Ph prog[] = {
  PH_A_LAYER(0), PH_A_LAYER(1),
  {OP_GLAT, O_XN, O_WD0, 6, 768, 1024, 7, 288, 0.f, 0.f, 0, 4},
  {OP_GB, O_CKV, O_WUKV, O_KVB, 2048, 256, 2048, 0, 1.f, 1.f, 1, 6},
  {OP_GB, O_CQ, O_WUQ, O_QB, 1536, 384, 1536, 0, 1.f, C2_MLA, 0, 7},
  {OP_ATTB, 0, 0, 0, 0, 0, 0, 0, 0.f, 0.f, 0, 0},
  {OP_GRES, O_OB, O_WOM, 0, 1024, 1024, 1024, 38, 0.f, 0.f, 0, 9},
  {OP_GR2, O_XN, O_W1B, O_H2, 2048, 1024, 2048, 0, 1.f, 1.f, 0, 9},
  {OP_GRES, O_H2, O_W2B, 0, 1024, 2048, 1024, 54, 0.f, 0.f, 0, 0},
  {OP_GR2, O_XN, O_W1B + 4 * MB, O_H2, 2048, 1024, 2048, 0, 1.f, 1.f, 0, 9},
  {OP_GRES, O_H2, O_W2B + 4 * MB, 0, 1024, 2048, 1024, 42, 0.f, 0.f, 0, 5},
  {OP_GLAT, O_XN, O_WD1, 0, 512, 1024, 8, 0, 0.f, 0.f, 0, 5},
  {OP_GB, O_CQ, O_WUQ + 1152 * KB, O_QB, 1536, 384, 1536, 0, 1.f, C2_MLA, 0, 8},
  {OP_ATTB, 0, 0, 0, 0, 0, 0, 0, 0.f, 0.f, 0, 0},
  {OP_GRES, O_OB, O_WOM + 2 * MB, 0, 1024, 1024, 1024, 38, 0.f, 0.f, 0, 10},
  {OP_GR2, O_XN, O_W1B + 8 * MB, O_H, 4096, 1024, 4096, 0, 1.f, 1.f, 0, 10},
  {OP_GRES, O_H, O_W2B + 8 * MB, 0, 1024, 4096, 1024, 38, 0.f, 0.f, 0, 11},
  {OP_FINAL, 0, 0, 0, 0, 0, 0, 0, 0.f, 0.f, 1, 0},
};
constexpr int NPH = sizeof(prog) / sizeof(Ph);

constexpr int RING_OFF = 0, RING_BYTES = 131072;
constexpr int LDSCTL_OFF = RING_BYTES, MISC_OFF = LDSCTL_OFF + 320;
constexpr int LDS_BYTES = 147456;
static_assert(att::LDS_BYTES <= RING_BYTES, "attention LDS");
__device__ __forceinline__ float wave_sum(float v) {
#pragma unroll
    for (int o = 1; o < 64; o <<= 1) v += __shfl_xor(v, o);
    return v;
}
__device__ __forceinline__ unsigned cvtpk2(float lo, float hi) { unsigned r; asm("v_cvt_pk_bf16_f32 %0, %1, %2" : "=v"(r) : "v"(lo), "v"(hi)); return r; }
struct P0Job { const float* W; const float* g; int K, N; bf16* WT; int row_off, item; };
#define P0_LOAD(J, wv) do { const int nblk_ = (J).N / 32, k0_ = 64 * ((J).item / nblk_), n0_ = 32 * ((J).item % nblk_);        \
    _Pragma("unroll") for (int i = 0; i < 8; ++i) (wv)[i] = __builtin_nontemporal_load((const GAS f32x4*)((J).W + (size_t)(k0_ + 8 * i + (lane >> 3)) * (J).N + n0_ + 4 * (lane & 7))); } while (0)
__device__ __forceinline__ void p0_finish(const P0Job& J, LAS float* scr, int lane) {
    const int nblk = J.N / 32, k0 = 64 * (J.item / nblk), n0 = 32 * (J.item % nblk);
    const int c = lane & 7;
    f32x4 g0 = (f32x4){1.f, 1.f, 1.f, 1.f}, g1 = g0;
    if (J.g) { g0 = *(const GAS f32x4*)(J.g + k0 + 8 * c); g1 = *(const GAS f32x4*)(J.g + k0 + 8 * c + 4); }
#pragma unroll
    for (int j = 0; j < 4; ++j) { const int n = (lane >> 3) + 8 * j; const LAS float* s = scr + (8 * c) * 33 + n;
        v4u o; o.x = cvtpk2(s[0 * 33] * g0.x, s[1 * 33] * g0.y); o.y = cvtpk2(s[2 * 33] * g0.z, s[3 * 33] * g0.w); o.z = cvtpk2(s[4 * 33] * g1.x, s[5 * 33] * g1.y); o.w = cvtpk2(s[6 * 33] * g1.z, s[7 * 33] * g1.w);
        *(GAS v4u*)(J.WT + (size_t)(J.row_off + n0 + n) * J.K + k0 + 8 * c) = o; }
    LDS_WAIT(); asm volatile("" ::: "memory");
}
template <int NR, int MODE> __device__ __forceinline__ void rms_rows(const float* xrow, void* orow, const float* gain, int lane) {
    f32x4 v[NR][4]; float s2[NR];
#pragma unroll
    for (int r = 0; r < NR; ++r) { const GAS f32x4* xr = (const GAS f32x4*)(xrow + (size_t)r * D) + lane;
#pragma unroll
        for (int j = 0; j < 4; ++j) v[r][j] = __builtin_nontemporal_load(xr + 64 * j); }
#pragma unroll
    for (int r = 0; r < NR; ++r) { float t = 0.f;
#pragma unroll
        for (int j = 0; j < 4; ++j) t += (v[r][j].x * v[r][j].x + v[r][j].y * v[r][j].y) + (v[r][j].z * v[r][j].z + v[r][j].w * v[r][j].w);
        s2[r] = t; }
#pragma unroll
    for (int o = 1; o < 64; o <<= 1) {
#pragma unroll
        for (int r = 0; r < NR; ++r) s2[r] += __shfl_xor(s2[r], o); }
#pragma unroll
    for (int r = 0; r < NR; ++r) { const float rr = 1.f / sqrtf(s2[r] * (1.f / D) + NORM_EPS);
        if (MODE == 0) { GAS unsigned long long* o8 = (GAS unsigned long long*)((bf16*)orow + (size_t)r * D) + lane;
#pragma unroll
            for (int j = 0; j < 4; ++j) o8[64 * j] = (unsigned long long)cvtpk2(v[r][j].x * rr, v[r][j].y * rr) | ((unsigned long long)cvtpk2(v[r][j].z * rr, v[r][j].w * rr) << 32); }
        else { GAS f32x4* of = (GAS f32x4*)((float*)orow + (size_t)r * D) + lane;
#pragma unroll
            for (int j = 0; j < 4; ++j) { const f32x4 gg = *((const GAS f32x4*)gain + lane + 64 * j); of[64 * j] = v[r][j] * rr * gg; } } }
}

#ifndef REP_ATTA
#define REP_ATTA 1
#endif
#ifndef REP_P0
#define REP_P0 1
#endif
#ifndef REP_GR2
#define REP_GR2 1
#endif
#ifndef REP_ATTB
#define REP_ATTB 1
#endif
#ifndef PROBE_MODE
#define PROBE_MODE 0
#endif
struct Args { const float* in[17]; float* out; unsigned char* ws; };
__global__ void __launch_bounds__(NWAVES * 64, 2) fwd(Args args) {
    extern __shared__ __attribute__((aligned(16))) unsigned char lds[];
    LAS unsigned char* L = (LAS unsigned char*)lds;
    volatile LAS unsigned* MISC = (volatile LAS unsigned*)(L + MISC_OFF);
    const int tid = threadIdx.x, lane = tid & 63, wave = __builtin_amdgcn_readfirstlane(tid >> 6);
    const int G = gridDim.x; const int bx = blockIdx.x; const int vcu = (G % 8 == 0) ? (bx % 8) * (G / 8) + bx / 8 : bx;
    unsigned char* ws = args.ws;
    for (int u = tid; u < (LDS_BYTES - LDSCTL_OFF) / 4; u += NWAVES * 64) ((LAS unsigned*)(L + LDSCTL_OFF))[u] = 0u;
    __syncthreads();
    XcdBarrier bar = xcd_barrier_post((unsigned*)(ws + O_CTL), MISC + 8);
    const int gw = vcu * NWAVES + wave, NGW = G * NWAVES;
    float* X = args.out;

    for (int rep0_ = 0; rep0_ < REP_P0; ++rep0_)
    {
        LAS float* scr = (LAS float*)(L + RING_OFF + wave * 16384);
        const float* attn_norm = args.in[2]; const float* mlp_norm = args.in[3];
#define P0_TRY(Wp, gp, K_, N_, WTo, roff) { const int items_ = ((K_) / 64) * ((N_) / 32); if (!hit_ && r_ < items_) { J_.W = (Wp); J_.g = (gp); J_.K = (K_); J_.N = (N_); J_.WT = (bf16*)(ws + (WTo)); J_.row_off = (roff); J_.item = r_; hit_ = true; } r_ -= items_; }
#define P0_DECODE(id, J) do { P0Job& J_ = (J); int r_ = (id); bool hit_ = false; \
        for (int l = 0; l < 4; ++l) { P0_TRY(args.in[14] + (size_t)l * D * FF, mlp_norm + l * D, D, FF, (l < 2 ? O_W1A + l * 8 * MB : O_W1B + (l - 2) * 8 * MB), 0) \
            if (l != 2) P0_TRY(args.in[15] + (size_t)l * FF * D, (const float*)nullptr, FF, D, (l < 2 ? O_W2A + l * 8 * MB : O_W2B + (l - 2) * 8 * MB), 0) \
            else { P0_TRY(args.in[15] + (size_t)l * FF * D, (const float*)nullptr, 2048, D, O_W2B, 0) \
                   P0_TRY(args.in[15] + (size_t)l * FF * D + (size_t)2048 * D, (const float*)nullptr, 2048, D, O_W2B + 4 * MB, 0) } } \
        for (int l = 0; l < 2; ++l) { P0_TRY(args.in[4] + (size_t)l * D * 3072, attn_norm + l * D, D, 3072, O_WQKV + l * 6 * MB, 0) \
            P0_TRY(args.in[5] + (size_t)l * D * D, (const float*)nullptr, D, D, O_WOSB + l * 2 * MB, 0) \
            P0_TRY(args.in[12] + (size_t)l * 384 * 1536, args.in[11] + l * 384, 384, 1536, O_WUQ + l * 1152 * KB, 0) \
            P0_TRY(args.in[13] + (size_t)l * D * D, (const float*)nullptr, D, D, O_WOM + l * 2 * MB, 0) } \
        P0_TRY(args.in[7], args.in[6], D, 288, O_WD0, 0) \
        P0_TRY(args.in[10], attn_norm + 2 * D, D, 384, O_WD0, 288) \
        P0_TRY(args.in[10] + (size_t)D * 384, attn_norm + 3 * D, D, 384, O_WD1, 0) \
        P0_TRY(args.in[9], args.in[8], 256, 2048, O_WUKV, 0) } while (0)
        constexpr int P0_TOTAL = 4 * 2048 + 4 * 2048 + 2 * (1536 + 512 + 288 + 512) + 144 + 192 + 192 + 256;
        if (gw < P0_TOTAL) {
            P0Job J0, J1; f32x4 wv[8];
            int id = gw; P0_DECODE(id, J0); P0_LOAD(J0, wv);
            for (;;) {
                const int idn = id + NGW; const bool more = idn < P0_TOTAL;
#pragma unroll
                for (int i = 0; i < 8; ++i) { LAS float* d_ = scr + (8 * i + (lane >> 3)) * 33 + 4 * (lane & 7); d_[0] = wv[i].x; d_[1] = wv[i].y; d_[2] = wv[i].z; d_[3] = wv[i].w; }
                LDS_WAIT(); asm volatile("" ::: "memory");
                if (more) { P0_DECODE(idn, J1); P0_LOAD(J1, wv); }
                p0_finish(J0, scr, lane);
                if (!more) break;
                J0 = J1; id = idn;
            }
        }
#undef P0_TRY
#undef P0_DECODE
        for (int i = gw * 64 + lane; i < 224 * 128; i += NGW * 64) { const int row = i >> 7, c16 = i & 127;
            bf16* dst = row < 96 ? (bf16*)(ws + O_WD0) + (size_t)(672 + row) * D : (bf16*)(ws + O_WD1) + (size_t)(384 + row - 96) * D;
            *(GAS v4u*)(dst + c16 * 8) = (v4u){0u, 0u, 0u, 0u}; }
        for (int i = gw * 64 + lane; i < N_RS * M / 2; i += NGW * 64) *((GAS f32x4*)(ws + O_RS) + i) = (f32x4){0.f, 0.f, 0.f, 0.f};
        { const int* pos = (const int*)args.in[1]; float* CS = (float*)(ws + O_CS);
          for (int i = gw * 64 + lane; i < M * 16; i += NGW * 64) { const int m = i >> 4, k = i & 15;
              const double bs = (k & 3) == 0 ? 1.0 : (k & 3) == 1 ? 0.5623413251903491 : (k & 3) == 2 ? 0.31622776601683794 : 0.1778279410038923;
              const double sc = (k >> 2) == 0 ? 1.0 : (k >> 2) == 1 ? 0.1 : (k >> 2) == 2 ? 0.01 : 0.001;
              const float inv = (float)(bs * sc); const float ang = (float)pos[m] * inv;
              const double rev = (double)ang * 0.15915494309189535; const float fr = (float)(rev - __builtin_rint(rev));
              CS[m * 32 + k] = __builtin_amdgcn_cosf(fr); CS[m * 32 + 16 + k] = __builtin_amdgcn_sinf(fr); } }
        for (int m = 4 * gw; m < M; m += 4 * NGW) rms_rows<4, 0>(args.in[0] + (size_t)m * D, (bf16*)(ws + O_XN) + (size_t)m * D, nullptr, lane);
    }
    if (__builtin_expect(ws == nullptr, 0)) cg::this_grid().sync();
    xcd_barrier(bar);

    const int lane0 = lane;
    for (int ph = 0; ph < NPH; ++ph) {
        const int op = prog[ph].op;
        int lane = lane0; asm volatile("" : "+v"(lane));
        if (op <= OP_GLAT) {
#ifndef NO_GEMM
            pg8::Gemm g{(const bf16*)(ws + prog[ph].a), (const bf16*)(ws + prog[ph].b), M, prog[ph].N, prog[ph].K};
            pg8::StaticOrder S; S.init(M, prog[ph].N, G, bx);
            const int rsi = prog[ph].rs; pg8::rs_t* rsp = rsi ? (pg8::rs_t*)(ws + O_RS) + (size_t)(rsi - 1) * M : nullptr;
            if (op == OP_GB) { pg8::EpiBf16<0> E{(bf16*)(ws + prog[ph].c), prog[ph].ldc, prog[ph].p0, (size_t)M * 1024, prog[ph].s0, prog[ph].s1, rsp, 1.f / (float)prog[ph].K};
                pg8::gemm_phase<pg8::EpiBf16<0>, pg8::StaticOrder, true, true>(L + RING_OFF, g, S, E); }
            else if (op == OP_GR2) { for (int rep_ = 1; rep_ < REP_GR2; ++rep_) { pg8::EpiBf16<2> E{(bf16*)(ws + prog[ph].c), prog[ph].ldc, 0, 0, 1.f, 1.f, rsp, 1.f / 1024.f};
                pg8::gemm_phase<pg8::EpiBf16<2>, pg8::StaticOrder, true, true>(L + RING_OFF, g, S, E); }
                pg8::EpiBf16<2> E{(bf16*)(ws + prog[ph].c), prog[ph].ldc, 0, 0, 1.f, 1.f, rsp, 1.f / 1024.f};
                pg8::gemm_phase<pg8::EpiBf16<2>, pg8::StaticOrder, true, true>(L + RING_OFF, g, S, E); }
            else if (op == OP_GRES) { const int fl = prog[ph].p0;
                bf16* XNp = (bf16*)(ws + O_XN); bf16* XN2p = (bf16*)(ws + O_OB);
                pg8::EpiF32<true> E{(fl & 1) ? args.in[0] : X, (fl & 2) ? nullptr : X, prog[ph].ldc, (fl & 32) ? ((fl & 16) ? XN2p : XNp) : nullptr, rsp, (fl & 4) ? XNp : (fl & 8) ? XN2p : nullptr};
                pg8::gemm_phase<pg8::EpiF32<true>, pg8::StaticOrder, true, true>(L + RING_OFF, g, S, E); }
            else { pg8::rs_t* rsb = (pg8::rs_t*)(ws + O_RS); const int ik = (int)prog[ph].c, iq = prog[ph].ldc;
                pg8::EpiLat E{rsp, prog[ph].p0, (bf16*)(ws + O_CKV), (bf16*)(ws + O_KR), (bf16*)(ws + O_CQ), ik ? rsb + (size_t)(ik - 1) * M : nullptr, rsb + (size_t)(iq - 1) * M, (const float*)(ws + O_CS)};
                pg8::gemm_phase<pg8::EpiLat, pg8::StaticOrder, true, true>(L + RING_OFF, g, S, E); }
#endif
        } else if (op == OP_ATTA) {
            att::ALAS_char_t wl = (att::ALAS_char_t)(L + RING_OFF + wave * 16384);
            att::SbConsts tc; att::sb_consts(tc, lane);
#ifndef NO_ATTA
            for (int rep_ = 0; rep_ < REP_ATTA; ++rep_)
            for (int u = gw; u < 32 * 256; u += NGW) { const int bh = u >> 8, qblk = u & 255;
                att::sb_unit(bh >> 4, bh & 15, qblk, (const bf16*)(ws + O_Q), (const bf16*)(ws + O_K), (const bf16*)(ws + O_V), (bf16*)(ws + O_OA), wl, tc); }
#endif
        } else if (op == OP_ATTB) {
#ifndef NO_ATTB
            for (int rep_ = 0; rep_ < REP_ATTB; ++rep_)
            for (int i = 0; ; ++i) { int bh, qb;
                if (G == 256) { if (i >= 4) break; const int c = vcu & 31; bh = (vcu >> 5) * 4 + i; qb = (i & 1) ? 31 - c : c; }
                else { const int id = vcu + i * G; if (id >= 1024) break; bh = id & 31; qb = 31 - (id >> 5); }
                att::mla_unit<8>(bh >> 4, bh & 15, qb, (const bf16*)(ws + O_QB), (const bf16*)(ws + O_KVB), (const bf16*)(ws + O_KR), (const float*)(ws + O_CS), (bf16*)(ws + O_OB), (att::ALAS_char_t)(L + RING_OFF)); }
#endif
        } else if (op == OP_NORM) {
            for (int m = 4 * gw; m < M; m += 4 * NGW) rms_rows<4, 0>(X + (size_t)m * D, (bf16*)(ws + O_XN) + (size_t)m * D, nullptr, lane);
        } else {
            const float* gfin = args.in[16]; const bf16* XB = (const bf16*)(ws + O_XN); const pg8::rs_t* rsf = (const pg8::rs_t*)(ws + O_RS) + (size_t)10 * M;
            f32x4 gg[4];
#pragma unroll
            for (int j = 0; j < 2; ++j) { gg[2 * j] = *(const GAS f32x4*)(gfin + 512 * j + 8 * lane); gg[2 * j + 1] = *(const GAS f32x4*)(gfin + 512 * j + 8 * lane + 4); }
            for (int m = 4 * gw; m < M; m += 4 * NGW) { v4u xv[4][2]; float rv[4];
#pragma unroll
                for (int r = 0; r < 4; ++r) { xv[r][0] = __builtin_nontemporal_load((const GAS v4u*)(XB + (size_t)(m + r) * D + 8 * lane)); xv[r][1] = __builtin_nontemporal_load((const GAS v4u*)(XB + (size_t)(m + r) * D + 512 + 8 * lane)); rv[r] = pg8::rs_get(rsf + m + r); }
#pragma unroll
                for (int r = 0; r < 4; ++r) { const float rr = 1.f / sqrtf(rv[r] * (1.f / D) + NORM_EPS);
#pragma unroll
                    for (int j = 0; j < 2; ++j) { const v4u w = xv[r][j]; float* o = X + (size_t)(m + r) * D + 512 * j + 8 * lane;
                        __builtin_nontemporal_store((f32x4){__uint_as_float(w.x << 16), __uint_as_float(w.x & 0xffff0000u), __uint_as_float(w.y << 16), __uint_as_float(w.y & 0xffff0000u)} * rr * gg[2 * j], (GAS f32x4*)(o));
                        __builtin_nontemporal_store((f32x4){__uint_as_float(w.z << 16), __uint_as_float(w.z & 0xffff0000u), __uint_as_float(w.w << 16), __uint_as_float(w.w & 0xffff0000u)} * rr * gg[2 * j + 1], (GAS f32x4*)(o + 4)); } } }
        }
        if (!prog[ph].nosync) xcd_barrier(bar);
    }
}

extern "C" void kernel_launch(void* const* d_in, const int* in_sizes, int n_in, void* d_out, int out_size, void* d_ws, size_t ws_size, hipStream_t stream) {
    static int grid = 0;
    if (grid == 0) {
        if (n_in != 17 || in_sizes[0] != M * D || out_size != M * D || ws_size < WS_NEED) { fprintf(stderr, "kernel_launch: unexpected shapes (n_in %d, out %d, ws %zu); nothing launched\n", n_in, out_size, ws_size); grid = -1; return; }
        int dev = 0, cus = 0, per_cu = 0;
        if (hipGetDevice(&dev) != hipSuccess || hipDeviceGetAttribute(&cus, hipDeviceAttributeMultiprocessorCount, dev) != hipSuccess) { grid = -1; return; }
        if (hipFuncSetAttribute((const void*)fwd, hipFuncAttributeMaxDynamicSharedMemorySize, LDS_BYTES) != hipSuccess) { fprintf(stderr, "kernel_launch: hipFuncSetAttribute failed\n"); grid = -1; return; }
        if (hipOccupancyMaxActiveBlocksPerMultiprocessor(&per_cu, (const void*)fwd, NWAVES * 64, LDS_BYTES) != hipSuccess || per_cu < 1) { fprintf(stderr, "kernel_launch: occupancy query says %d\n", per_cu); per_cu = 1; }
        (void)hipGetLastError();
        grid = cus;
    }
    if (grid < 0) return;
    (void)hipMemsetAsync((char*)d_ws + O_CTL, 0, CTL_ZERO_BYTES, stream);
    Args a{};
    for (int i = 0; i < 17; ++i) a.in[i] = (const float*)d_in[i];
    a.out = (float*)d_out; a.ws = (unsigned char*)d_ws;
    void* kargs[] = {&a};
    const hipError_t le = hipLaunchCooperativeKernel((const void*)fwd, dim3(grid), dim3(NWAVES * 64), kargs, LDS_BYTES, stream);
    if (le != hipSuccess) fprintf(stderr, "kernel_launch: cooperative launch failed: %s (grid %d)\n", hipGetErrorName(le), grid);
}
```
